# Optimizing an MI355X kernel written in HIP

```python
import math
import jax, jax.numpy as jnp
from jax import lax
import numpy as np

D_MODEL = 2048
BATCH = 2
SEQ = 4096
DEPTH = 1
DEC_BATCH = 8
DEC_SEQ = 4
PAST_LEN = 16384
PAGE_SIZE = 128

RET_HEADS = 8
RET_DK = 128
RET_DV = 128
RET_CHUNK = 128
RET_THETA = 10000.0
DSA_HEADS = 8
DSA_KV_HEADS = 2
DSA_DH = 128
IDX_HEADS = 16
IDX_DH = 64
TOPK_MAX = 256
Q_BLOCK = 128
ROPE_THETA = 500000.0
ROPE_FRAC = 4
MEM_LEN = 256
MEM_HEADS = 4
MEM_DH = 128
D_FF = 4 * D_MODEL
EPS = 1e-6

RET_QK = RET_HEADS * RET_DK
RET_VW = RET_HEADS * RET_DV
DSA_QW = DSA_HEADS * DSA_DH
DSA_KVW = DSA_KV_HEADS * DSA_DH
IDX_QW = IDX_HEADS * IDX_DH
IN_SPLITS = (RET_QK, RET_QK, RET_VW, RET_VW, DSA_QW, DSA_KVW, DSA_KVW, IDX_QW, IDX_DH, IDX_HEADS, D_MODEL, D_MODEL)
N_IN = 2 * RET_QK + 2 * RET_VW + DSA_QW + 2 * DSA_KVW + IDX_QW + IDX_DH + IDX_HEADS + 2 * D_MODEL
MEM_W = MEM_HEADS * MEM_DH

kernel_name = 'retention_dsa_gated_hybrid_step'


def rmsnorm(x, g):
    xf = x.astype(jnp.float32)
    y = xf * lax.rsqrt(jnp.mean(xf * xf, axis=-1, keepdims=True) + EPS)
    return (y * g.astype(jnp.float32)).astype(x.dtype)


def rope(x, pos, n_rot, theta):
    half = n_rot // 2
    inv = theta ** (-jnp.arange(half, dtype=jnp.float32) / half)
    ang = pos.astype(jnp.float32)[:, None] * inv[None, :]
    cos = jnp.cos(ang)[:, None, :]
    sin = jnp.sin(ang)[:, None, :]
    xr = x[..., :n_rot].astype(jnp.float32)
    x1, x2 = xr[..., :half], xr[..., half:]
    rot = jnp.concatenate([x1 * cos - x2 * sin, x2 * cos + x1 * sin], axis=-1)
    return jnp.concatenate([rot.astype(x.dtype), x[..., n_rot:]], axis=-1)


def mixer_inputs(u, pos, w_in):
    B, T, _ = u.shape
    h = jnp.einsum('btd,dn->btn', u, w_in)
    parts = []
    o = 0
    for n in IN_SPLITS:
        parts.append(h[..., o:o + n])
        o += n
    rq, rk, rv, rg, dq, dk, dv, iq, ik, iw, ga, gb = parts
    rq = rope(rq.reshape(B, T, RET_HEADS, RET_DK), pos, RET_DK, RET_THETA)
    rk = rope(rk.reshape(B, T, RET_HEADS, RET_DK), pos, RET_DK, RET_THETA) * (RET_DK ** -0.5)
    rv = rv.reshape(B, T, RET_HEADS, RET_DV)
    dq = rope(dq.reshape(B, T, DSA_HEADS, DSA_DH), pos, DSA_DH // ROPE_FRAC, ROPE_THETA)
    dk = rope(dk.reshape(B, T, DSA_KV_HEADS, DSA_DH), pos, DSA_DH // ROPE_FRAC, ROPE_THETA)
    dv = dv.reshape(B, T, DSA_KV_HEADS, DSA_DH)
    iq = rope(iq.reshape(B, T, IDX_HEADS, IDX_DH), pos, IDX_DH // ROPE_FRAC, ROPE_THETA)
    ik = rope(ik.reshape(B, T, 1, IDX_DH), pos, IDX_DH // ROPE_FRAC, ROPE_THETA)[:, :, 0]
    return rq, rk, rv, rg, dq, dk, dv, iq, ik, iw, ga, gb


def retention(q, k, v, state0):
    B, T, H, dk = q.shape
    dv = v.shape[-1]
    C = RET_CHUNK if T % RET_CHUNK == 0 else T
    n = T // C
    log_g = jnp.log1p(-jnp.exp2(-5.0 - jnp.arange(H, dtype=jnp.float32)))
    j = jnp.arange(C, dtype=jnp.float32)
    diff = j[:, None] - j[None, :]
    intra = jnp.where(diff >= 0, jnp.exp(log_g[:, None, None] * jnp.maximum(diff, 0.0)), 0.0)
    q_dec = jnp.exp(log_g[None, :] * (j[:, None] + 1.0))[None, :, :, None]
    k_dec = jnp.exp(log_g[None, :] * (C - 1.0 - j[:, None]))[None, :, :, None]
    c_dec = jnp.exp(log_g * C)[None, :, None, None]

    def to_chunks(a):
        return a.astype(jnp.float32).reshape(B, n, C, H, a.shape[-1]).swapaxes(0, 1)

    def step(S, inp):
        qc, kc, vc = inp
        s = jnp.einsum('bihd,bjhd->bhij', qc, kc) * intra[None]
        o = jnp.einsum('bhij,bjhe->bihe', s, vc) + jnp.einsum('bihd,bhde->bihe', qc, S) * q_dec
        S = S * c_dec + jnp.einsum('bjhd,bjhe->bhde', kc * k_dec, vc)
        return S, o

    S, o = lax.scan(step, state0.astype(jnp.float32), (to_chunks(q), to_chunks(k), to_chunks(v)))
    return o.swapaxes(0, 1).reshape(B, T, H, dv), S


def index_select(iq, iw, ik, qpos, topk):
    L = ik.shape[1]
    dots = jnp.einsum('bthd,bsd->bths', iq, ik, preferred_element_type=jnp.float32)
    score = jnp.einsum('bths,bth->bts', jax.nn.relu(dots), iw.astype(jnp.float32))
    admissible = jnp.arange(L)[None, None, :] <= qpos[None, :, None]
    score = jnp.where(admissible, score, -jnp.inf)
    _, idx = lax.top_k(score, topk)
    valid = idx <= qpos[None, :, None]
    return idx, valid


gather_rows = jax.vmap(lambda a, i: a[i])


def sparse_attend(q, kg, vg, valid):
    B, T, H, dh = q.shape
    hkv = kg.shape[3]
    qg = q.reshape(B, T, hkv, H // hkv, dh)
    logits = jnp.einsum('btkgd,btnkd->btkgn', qg, kg, preferred_element_type=jnp.float32) * (dh ** -0.5)
    logits = jnp.where(valid[:, :, None, None, :], logits, -jnp.inf)
    p = jax.nn.softmax(logits, axis=-1).astype(vg.dtype)
    o = jnp.einsum('btkgn,btnkd->btkgd', p, vg)
    return o.reshape(B, T, H, dh)


def dsa_prompt(q, k, v, iq, ik, iw):
    B, S, H, dh = q.shape
    topk = min(TOPK_MAX, S // 4)

    def block(bi):
        start = bi * Q_BLOCK
        sl = lambda a: lax.dynamic_slice_in_dim(a, start, Q_BLOCK, axis=1)
        qpos = start + jnp.arange(Q_BLOCK, dtype=jnp.int32)
        idx, valid = index_select(sl(iq), sl(iw), ik, qpos, topk)
        return sparse_attend(sl(q), gather_rows(k, idx), gather_rows(v, idx), valid)

    out = lax.map(block, jnp.arange(S // Q_BLOCK, dtype=jnp.int32))
    return out.swapaxes(0, 1).reshape(B, S, H, dh)


def dsa_sample(q, k, v, iq, ik, iw, pool_k, pool_v, pool_ik, page_table):
    DB, T = q.shape[:2]
    L = PAST_LEN + T
    topk = min(TOPK_MAX, L // 4)
    ik_past = pool_ik[page_table].reshape(DB, PAST_LEN, IDX_DH).astype(ik.dtype)
    ik_all = jnp.concatenate([ik_past, ik], axis=1)
    qpos = PAST_LEN + jnp.arange(T, dtype=jnp.int32)
    idx, valid = index_select(iq, iw, ik_all, qpos, topk)
    in_past = idx < PAST_LEN
    pidx = jnp.minimum(idx, PAST_LEN - 1)
    page = pidx // PAGE_SIZE
    off = pidx % PAGE_SIZE
    phys = jnp.take_along_axis(page_table, page.reshape(DB, -1), axis=1).reshape(page.shape)
    nidx = jnp.clip(idx - PAST_LEN, 0, T - 1)
    sel = in_past[..., None, None]
    kg = jnp.where(sel, pool_k[phys, off].astype(k.dtype), gather_rows(k, nidx))
    vg = jnp.where(sel, pool_v[phys, off].astype(v.dtype), gather_rows(v, nidx))
    return sparse_attend(q, kg, vg, valid)


def layer_tail(x, ret_o, rg, dsa_o, ga, gb, mk, mv, gn_ret, w_ret_out, w_dsa_out, w_o,
               g_mem, w_mq, w_mo, g_mlp, w_up, w_down):
    B, T, _ = x.shape
    mu = jnp.mean(ret_o, axis=-1, keepdims=True)
    var = jnp.mean(jnp.square(ret_o - mu), axis=-1, keepdims=True)
    ret_n = ((ret_o - mu) * lax.rsqrt(var + EPS)).reshape(B, T, -1) * gn_ret.astype(jnp.float32)
    ret_y = (jax.nn.silu(rg.astype(jnp.float32)) * ret_n).astype(x.dtype)
    ya = ret_y @ w_ret_out
    yb = dsa_o.reshape(B, T, -1) @ w_dsa_out
    merged = jax.nn.sigmoid(ga) * ya + jax.nn.sigmoid(gb) * yb
    h = x + merged @ w_o
    qm = (rmsnorm(h, g_mem) @ w_mq).reshape(B, T, MEM_HEADS, MEM_DH)
    logits = jnp.einsum('bthd,bmhd->bhtm', qm, mk.astype(qm.dtype), preferred_element_type=jnp.float32) * (MEM_DH ** -0.5)
    p = jax.nn.softmax(logits, axis=-1).astype(qm.dtype)
    om = jnp.einsum('bhtm,bmhd->bthd', p, mv.astype(qm.dtype)).reshape(B, T, -1)
    h = h + om @ w_mo
    u = rmsnorm(h, g_mlp)
    h = h + jnp.square(jax.nn.relu(u @ w_up)) @ w_down
    return h


def setup_inputs(seed: int = 0) -> dict:
    key = jax.random.key(seed)
    ks = iter(list(jax.random.split(key, 40)))
    f32 = jnp.float32
    n_pages = PAST_LEN // PAGE_SIZE
    n_used = DEC_BATCH * n_pages
    n_pool = n_used + n_used // 4

    def nrm(shape, scale):
        return jax.random.normal(next(ks), shape, f32) * scale

    def gain(shape):
        return 1.0 + 0.01 * jax.random.normal(next(ks), shape, f32)

    page_table = jax.random.permutation(next(ks), n_pool)[:n_used].reshape(DEC_BATCH, n_pages).astype(jnp.int32)
    return {
        'x_prompt': nrm((BATCH, SEQ, D_MODEL), 1.0),
        'x_sample': nrm((DEC_BATCH, DEC_SEQ, D_MODEL), 1.0),
        'mem_prompt': nrm((BATCH, MEM_LEN, D_MODEL), 1.0),
        'cache_k': nrm((DEPTH, n_pool, PAGE_SIZE, DSA_KV_HEADS, DSA_DH), 1.0),
        'cache_v': nrm((DEPTH, n_pool, PAGE_SIZE, DSA_KV_HEADS, DSA_DH), 1.0),
        'cache_idx_k': nrm((DEPTH, n_pool, PAGE_SIZE, IDX_DH), 1.0),
        'state_ret': nrm((DEPTH, DEC_BATCH, RET_HEADS, RET_DK, RET_DV), 0.1),
        'cache_mem_k': nrm((DEPTH, DEC_BATCH, MEM_LEN, MEM_HEADS, MEM_DH), 1.0),
        'cache_mem_v': nrm((DEPTH, DEC_BATCH, MEM_LEN, MEM_HEADS, MEM_DH), 1.0),
        'page_table': page_table,
        'g_mix': gain((DEPTH, D_MODEL)),
        'w_in': nrm((DEPTH, D_MODEL, N_IN), D_MODEL ** -0.5),
        'gn_ret': gain((DEPTH, RET_VW)),
        'w_ret_out': nrm((DEPTH, RET_VW, D_MODEL), RET_VW ** -0.5),
        'w_dsa_out': nrm((DEPTH, DSA_QW, D_MODEL), DSA_QW ** -0.5),
        'w_o': nrm((DEPTH, D_MODEL, D_MODEL), D_MODEL ** -0.5),
        'g_mem': gain((DEPTH, D_MODEL)),
        'g_memkv': gain((DEPTH, D_MODEL)),
        'w_mq': nrm((DEPTH, D_MODEL, MEM_W), D_MODEL ** -0.5),
        'w_mk': nrm((DEPTH, D_MODEL, MEM_W), D_MODEL ** -0.5),
        'w_mv': nrm((DEPTH, D_MODEL, MEM_W), D_MODEL ** -0.5),
        'w_mo': nrm((DEPTH, MEM_W, D_MODEL), MEM_W ** -0.5),
        'g_mlp': gain((DEPTH, D_MODEL)),
        'w_up': nrm((DEPTH, D_MODEL, D_FF), D_MODEL ** -0.5),
        'w_down': nrm((DEPTH, D_FF, D_MODEL), D_FF ** -0.5),
        'g_final': gain((D_MODEL,)),
    }


def reference(x_prompt, x_sample, mem_prompt, cache_k, cache_v, cache_idx_k, state_ret, cache_mem_k, cache_mem_v,
              page_table, g_mix, w_in, gn_ret, w_ret_out, w_dsa_out, w_o, g_mem, g_memkv, w_mq, w_mk, w_mv, w_mo,
              g_mlp, w_up, w_down, g_final):
    B, S, _ = x_prompt.shape
    DB, T, _ = x_sample.shape
    M = mem_prompt.shape[1]
    pos_p = jnp.arange(S, dtype=jnp.int32)
    pos_s = PAST_LEN + jnp.arange(T, dtype=jnp.int32)
    hp, hs = x_prompt, x_sample
    sp_l, kp_l, vp_l, ikp_l, mkp_l, mvp_l = [], [], [], [], [], []
    ss_l, ks_l, vs_l, iks_l = [], [], [], []
    for l in range(DEPTH):
        up = rmsnorm(hp, g_mix[l])
        rq, rk, rv, rg, dq, dk, dv, iq, ik, iw, ga, gb = mixer_inputs(up, pos_p, w_in[l])
        ret_o, st = retention(rq, rk, rv, jnp.zeros((B, RET_HEADS, RET_DK, RET_DV), jnp.float32))
        dsa_o = dsa_prompt(dq, dk, dv, iq, ik, iw)
        mn = rmsnorm(mem_prompt, g_memkv[l])
        mk = (mn @ w_mk[l]).reshape(B, M, MEM_HEADS, MEM_DH)
        mv = (mn @ w_mv[l]).reshape(B, M, MEM_HEADS, MEM_DH)
        hp = layer_tail(hp, ret_o, rg, dsa_o, ga, gb, mk, mv, gn_ret[l], w_ret_out[l], w_dsa_out[l], w_o[l],
                        g_mem[l], w_mq[l], w_mo[l], g_mlp[l], w_up[l], w_down[l])
        sp_l.append(st); kp_l.append(dk); vp_l.append(dv); ikp_l.append(ik); mkp_l.append(mk); mvp_l.append(mv)
        us = rmsnorm(hs, g_mix[l])
        rq, rk, rv, rg, dq, dk, dv, iq, ik, iw, ga, gb = mixer_inputs(us, pos_s, w_in[l])
        ret_o, st = retention(rq, rk, rv, state_ret[l])
        dsa_o = dsa_sample(dq, dk, dv, iq, ik, iw, cache_k[l], cache_v[l], cache_idx_k[l], page_table)
        hs = layer_tail(hs, ret_o, rg, dsa_o, ga, gb, cache_mem_k[l], cache_mem_v[l], gn_ret[l], w_ret_out[l],
                        w_dsa_out[l], w_o[l], g_mem[l], w_mq[l], w_mo[l], g_mlp[l], w_up[l], w_down[l])
        ss_l.append(st); ks_l.append(dk); vs_l.append(dv); iks_l.append(ik)
    y_prompt = rmsnorm(hp, g_final)
    y_sample = rmsnorm(hs, g_final)
    ret_state_prompt = jnp.stack(sp_l)
    k_rows_prompt = jnp.stack(kp_l)
    v_rows_prompt = jnp.stack(vp_l)
    idx_k_rows_prompt = jnp.stack(ikp_l)
    mem_k_prompt = jnp.stack(mkp_l)
    mem_v_prompt = jnp.stack(mvp_l)
    ret_state_sample = jnp.stack(ss_l)
    k_rows_sample = jnp.stack(ks_l)
    v_rows_sample = jnp.stack(vs_l)
    idx_k_rows_sample = jnp.stack(iks_l)
    return (y_prompt, y_sample, ret_state_prompt, k_rows_prompt, v_rows_prompt, idx_k_rows_prompt,
            mem_k_prompt, mem_v_prompt, ret_state_sample, k_rows_sample, v_rows_sample, idx_k_rows_sample)
```

```cpp
#include <hip/hip_runtime.h>
#include <cstdio>
#include <cstdint>

#define LAS __attribute__((address_space(3)))
#define GAS __attribute__((address_space(1)))
typedef unsigned short bf16_t;
typedef short bf16x8 __attribute__((ext_vector_type(8)));
typedef short s16x4 __attribute__((ext_vector_type(4)));
typedef float f32x2 __attribute__((ext_vector_type(2)));
typedef float f32x4 __attribute__((ext_vector_type(4)));
typedef float f32x16 __attribute__((ext_vector_type(16)));
typedef unsigned u32x2 __attribute__((ext_vector_type(2)));
typedef unsigned u32x4 __attribute__((ext_vector_type(4)));
typedef unsigned long long u64;

constexpr int DM = 2048, SEQ = 4096, MP = 8192, MS = 32, NIN = 10832, NV1 = 11008, DFF = 8192, MEMW = 512;
constexpr int PAST = 16384, NTPOS = 4100;
constexpr int SLEN = 16400;
constexpr float EPS = 1e-6f;
constexpr float QK_SCALE = 0.08838834764831845f;

constexpr size_t O_Y = 0, O_YS = 16777216, O_RSP = 16842752, O_KP = 17104896, O_VP = 19202048, O_IKP = 21299200, O_MK = 21823488, O_MV = 22085632,
                 O_RSS = 22347776, O_KS = 23396352, O_VS = 23404544, O_IKS = 23412736;

constexpr size_t MiB = 1u << 20, KiB = 1u << 10;
constexpr size_t WS_CTL = 0, CTL_ZERO_BYTES = 1 * MiB;
constexpr size_t WS_TAB = 1 * MiB;
constexpr size_t TAB_COS64 = 0, TAB_SIN64 = (size_t)NTPOS * 64 * 4, TAB_COS16 = 2 * TAB_SIN64, TAB_SIN16 = TAB_COS16 + (size_t)NTPOS * 16 * 4,
                 TAB_COS8 = TAB_SIN16 + (size_t)NTPOS * 16 * 4, TAB_SIN8 = TAB_COS8 + (size_t)NTPOS * 8 * 4;
static_assert(TAB_SIN8 + (size_t)NTPOS * 8 * 4 <= 3 * MiB, "tables");
constexpr size_t WS_SSQ = 4 * MiB;
constexpr size_t WS_WT1 = 8 * MiB;
constexpr size_t WS_WRO = 55 * MiB, WS_WDO = 59 * MiB, WS_WO = 63 * MiB, WS_WMQ = 71 * MiB, WS_WMO = 73 * MiB, WS_WUP = 75 * MiB, WS_WDN = 107 * MiB;
constexpr size_t WS_XN = 139 * MiB;
constexpr size_t WS_RQ = 173 * MiB, WS_RK = 189 * MiB, WS_RV = 205 * MiB, WS_RG = 221 * MiB;
constexpr size_t WS_DQ = 237 * MiB, WS_DK = 253 * MiB, WS_DV = 257 * MiB, WS_IQ = 261 * MiB, WS_IK = 277 * MiB, WS_IW = 278 * MiB;
constexpr size_t WS_GA = 279 * MiB, WS_GB = 311 * MiB;
constexpr size_t WS_SCORES = 343 * MiB;
constexpr size_t WS_KVC = 471 * MiB;
constexpr size_t WS_SPREV = 503 * MiB;
constexpr size_t WS_MASK = 519 * MiB;
constexpr size_t WS_RETY = 523 * MiB, WS_DSAO = 539 * MiB;
constexpr size_t WS_MERGED = 555 * MiB, WS_H1B = 587 * MiB, WS_QM = 619 * MiB, WS_OM = 627 * MiB, WS_MEMKB = 635 * MiB, WS_MEMVB = 638 * MiB;
constexpr size_t WS_SMP = 641 * MiB;
constexpr size_t WS_END = 665 * MiB;
constexpr size_t WS_T1 = WS_SCORES;
constexpr size_t WS_H1 = WS_RQ;
constexpr size_t WS_ACT = WS_SCORES;
constexpr size_t SM_XN = 0, SM_RQ = 512 * KiB, SM_RK = 1024 * KiB, SM_RV = 1536 * KiB, SM_RG = 2048 * KiB, SM_DQ = 2560 * KiB, SM_DK = 3072 * KiB, SM_DV = 3584 * KiB,
                 SM_IQ = 4096 * KiB, SM_IK = 4608 * KiB, SM_IW = 5120 * KiB, SM_GA = 5632 * KiB, SM_GB = 6144 * KiB, SM_RETY = 6656 * KiB, SM_DSAO = 7168 * KiB,
                 SM_MERGED = 7680 * KiB, SM_H1 = 8192 * KiB, SM_H1B = 8704 * KiB, SM_QM = 9216 * KiB, SM_OM = 9728 * KiB, SM_ACT = 10240 * KiB, SM_SIDX = 11264 * KiB,
                 SM_SSQ = 11776 * KiB  , SM_T1 = 12288 * KiB, SM_SCORE = 13 * MiB  ;

constexpr int CW_BAR = 4096;

constexpr int RING_BYTES = 131072, LDSCTL_OFF = RING_BYTES, MISC_OFF = LDSCTL_OFF + 320, LDS_BYTES = 147456;

__device__ __forceinline__ unsigned f2bf(float f) { unsigned u = __builtin_bit_cast(unsigned, f); return (u + 0x7fffu + ((u >> 16) & 1u)) >> 16; }
__device__ __forceinline__ unsigned pk2(float lo, float hi) { return f2bf(lo) | (f2bf(hi) << 16); }
__device__ __forceinline__ float bf2f(unsigned short b) { return __builtin_bit_cast(float, (unsigned)b << 16); }
__device__ __forceinline__ float bflo(unsigned w) { return __builtin_bit_cast(float, w << 16); }
__device__ __forceinline__ float bfhi(unsigned w) { return __builtin_bit_cast(float, w & 0xffff0000u); }
__device__ __forceinline__ float wave_sum(float v) {
#pragma unroll
    for (int o = 1; o < 64; o <<= 1) v += __shfl_xor(v, o);
    return v;
}
__device__ __forceinline__ float wave_max(float v) {
#pragma unroll
    for (int o = 1; o < 64; o <<= 1) v = fmaxf(v, __shfl_xor(v, o));
    return v;
}
__device__ __forceinline__ float sigmoidf_(float x) { return 1.0f / (1.0f + __expf(-x)); }
__device__ __forceinline__ float siluf_(float x) { return x / (1.0f + __expf(-x)); }
__device__ __forceinline__ int crow(int r, int hi) { return (r & 3) + 8 * (r >> 2) + 4 * hi; }
__device__ __forceinline__ float lg2g(int h) { return __log2f(1.0f - exp2f(-5.0f - (float)h)); }

__host__ __device__ inline int idx_e(int y) {
    const int n = (y >> 4) & 1, fq = (y >> 2) & 3, j = y & 3;
    return fq < 2 ? 8 * n + 4 * fq + j : 16 + 8 * n + 4 * (fq - 2) + j;
}
__host__ __device__ inline int win_real_col(int v) {
    const int tile = v >> 8, x8 = v & 255, bj = x8 >> 7, x = x8 & 127;
    if (tile < 8) { const int wc = x >> 5, n = (x >> 4) & 1, r = x & 15; return tile * 256 + bj * 128 + 64 * n + 16 * wc + r; }
    if (tile < 22) return v;
    if (tile < 26) { const int y = x & 63; return 5632 + (tile - 22) * 256 + bj * 128 + (x & 64) + (y < 32 ? idx_e(y) : y); }
    if (tile == 26) { if (x8 < 64) return 6656 + (x8 < 32 ? idx_e(x8) : x8); if (x8 < 80) return 6720 + (x8 - 64); return -1; }
    if (tile < 35) return 6736 + (v - 27 * 256);
    return 8784 + (v - 35 * 256);
}
namespace pg8 {
#define PG8_LAS __attribute__((address_space(3)))
typedef unsigned short bf16_t;
typedef short bf16x8 __attribute__((ext_vector_type(8)));
typedef float f32x4 __attribute__((ext_vector_type(4)));
typedef unsigned u32x4 __attribute__((ext_vector_type(4)));
constexpr int BM = 256, BK = 64, HALF = 128, HTB = HALF * BK * 2  , STAGE_BYTES = 8 * HTB, NXCD = 8, WGM = 8;

__host__ __device__ __forceinline__ int lds_byte(int r, int c) { const int st = (r >> 4) * 2 + (c >> 5), rr = r & 15, cc = c & 31, ob = rr * 64 + cc * 2; return st * 1024 + (ob ^ (((ob >> 9) & 1) << 5)); }
__host__ __device__ __forceinline__ void stage_rc(int b, int& R, int& C) { const int st = b / 1024, sb = b % 1024, swz = sb ^ (((sb >> 9) & 1) << 5); R = (st >> 1) * 16 + swz / 64; C = (st & 1) * 32 + (swz % 64) / 2; }
__host__ __device__ __forceinline__ int perm32(int rho) { const int n = rho >> 4, i = rho & 15; return 8 * (i >> 2) + 4 * n + (i & 3); }

struct Unit { int pm, pn; };
struct Gemm { const bf16_t* A; const bf16_t* Bt; int M, N, K; };

struct StaticOrder {
    int nM, nN, nwg, G, c;
    __host__ __device__ void init(int M, int N, int G_, int c_) { nM = M / BM; nN = N / BM; nwg = nM * nN; G = G_; c = c_; }
    __host__ __device__ bool next(int i, Unit& u) const {
        const long L = (long)i * G + c; if (L >= nwg) return false;
        int wgid = (int)L; { const int q = nwg / NXCD, r = nwg % NXCD, xcd = wgid % NXCD, off = wgid / NXCD; wgid = (xcd < r ? xcd * (q + 1) : r * (q + 1) + (xcd - r) * q) + off; }
        const int nig = WGM * nN, gid = wgid / nig, fm = gid * WGM, gsz = (nM - fm) < WGM ? (nM - fm) : WGM;
        u.pm = fm + ((wgid % nig) % gsz); u.pn = (wgid % nig) / gsz; return true;
    }
    __device__ __forceinline__ void a_ready(const Unit&) const {}
    __device__ __forceinline__ void done(const Unit&) const {}
};


template <class Epi, class Sched, bool ALIGN_EPI = false, bool SP2 = false>
__device__ __forceinline__ void gemm_phase(PG8_LAS unsigned char* lds, const Gemm g, const Sched& S, const Epi& E) {
    const int tid = threadIdx.x, wid = __builtin_amdgcn_readfirstlane(tid >> 6), lane = tid & 63, wr = wid >> 2, wc = wid & 3, fr = lane & 15, fq = lane >> 4;
    const int K = g.K, nt = K / BK;
    unsigned voffA[2], voffB[2];
#pragma unroll
    for (int i = 0; i < 2; ++i) { int R, C; stage_rc(tid * 16 + i * 8192, R, C); const int Rb = Epi::PERM ? ((R & ~31) + perm32(R & 31)) : R;
        voffA[i] = (unsigned)(R * K + C) * 2u; voffB[i] = (unsigned)(Rb * K + C) * 2u; }
    const size_t kstep = (size_t)(BK * 2);
    const size_t hstep = (size_t)HALF * K * 2;
    const size_t tstep = 2 * hstep;
    const unsigned ldsw = (unsigned)wid * 1024u;
    const int aoff = lds_byte(wr * 64 + fr, fq * 8), boff = lds_byte(wc * 32 + fr, fq * 8);
#define PG8_SA(b, h) (((b) * 2 + (h)) * HTB)
#define PG8_SB(b, h) ((4 + (b) * 2 + (h)) * HTB)
#define PG8_STAGE(bufoff, gbase, voff) do { _Pragma("unroll") for (int _i = 0; _i < 2; ++_i) \
        __builtin_amdgcn_global_load_lds((const unsigned*)((const char*)(gbase) + (voff)[_i]), (PG8_LAS unsigned*)(lds + (bufoff) + ldsw + _i * 8192), 16, 0, 0); } while (0)
#define PG8_LDA(dst, b, h) do { _Pragma("unroll") for (int m = 0; m < 4; ++m) _Pragma("unroll") for (int k = 0; k < 2; ++k) dst[m][k] = *(const PG8_LAS bf16x8*)(lds + PG8_SA(b, h) + aoff + m * 2048 + k * 1024); } while (0)
#define PG8_LDB(dst, b, h) do { _Pragma("unroll") for (int n = 0; n < 2; ++n) _Pragma("unroll") for (int k = 0; k < 2; ++k) dst[n][k] = *(const PG8_LAS bf16x8*)(lds + PG8_SB(b, h) + boff + n * 2048 + k * 1024); } while (0)
#define PG8_MMA(ai, bj, At, Bt) do { __builtin_amdgcn_s_setprio(1); _Pragma("unroll") for (int m = 0; m < 4; ++m) _Pragma("unroll") for (int n = 0; n < 2; ++n) _Pragma("unroll") for (int k = 0; k < 2; ++k) \
        acc[ai][bj][m][n] = __builtin_amdgcn_mfma_f32_16x16x32_bf16(Bt[n][k], At[m][k], acc[ai][bj][m][n], 0, 0, 0); __builtin_amdgcn_s_setprio(0); } while (0)
#define PG8_WAIT_V(n) asm volatile("s_waitcnt vmcnt(" #n ")" ::: "memory")
#define PG8_WAIT_L(n) asm volatile("s_waitcnt lgkmcnt(" #n ")" ::: "memory")
#define PG8_BAR __builtin_amdgcn_s_barrier()
#define PG8_SCHED __builtin_amdgcn_sched_barrier(0)
    Unit cur, nxt; int ui = 0;
    if (!S.next(0, cur)) return;
    f32x4 acc[2][2][4][2];
#pragma unroll
    for (int a = 0; a < 2; ++a)
#pragma unroll
        for (int b = 0; b < 2; ++b)
#pragma unroll
            for (int m = 0; m < 4; ++m)
#pragma unroll
                for (int n = 0; n < 2; ++n) acc[a][b][m][n] = (f32x4){0.f, 0.f, 0.f, 0.f};
    bf16x8 At[4][2], B0[2][2], B1[2][2];
    const char* cA = (const char*)g.A + (size_t)cur.pm * tstep; const char* cB = (const char*)g.Bt + (size_t)cur.pn * tstep;
    S.a_ready(cur);
    if constexpr (SP2) {
        PG8_STAGE(PG8_SB(0, 0), cB, voffB); PG8_STAGE(PG8_SB(0, 1), cB + hstep, voffB); PG8_STAGE(PG8_SA(0, 0), cA, voffA); PG8_STAGE(PG8_SA(0, 1), cA + hstep, voffA);
        if (wr == 1) PG8_BAR;
        PG8_WAIT_V(2); PG8_BAR;
        PG8_STAGE(PG8_SB(1, 0), cB + kstep, voffB); PG8_STAGE(PG8_SA(1, 0), cA + kstep, voffA); PG8_STAGE(PG8_SB(1, 1), cB + hstep + kstep, voffB);
        PG8_WAIT_V(6); PG8_BAR;
    } else {
        PG8_STAGE(PG8_SB(0, 0), cB, voffB); PG8_STAGE(PG8_SA(0, 0), cA, voffA); PG8_STAGE(PG8_SB(0, 1), cB + hstep, voffB); PG8_STAGE(PG8_SA(0, 1), cA + hstep, voffA);
        if (wr == 1) PG8_BAR;
        PG8_WAIT_V(4); PG8_BAR;
        PG8_STAGE(PG8_SB(1, 0), cB + kstep, voffB); PG8_STAGE(PG8_SA(1, 0), cA + kstep, voffA); PG8_STAGE(PG8_SB(1, 1), cB + hstep + kstep, voffB);
        PG8_WAIT_V(6); PG8_BAR;
    }
    for (;;) {
        const bool has_next = S.next(ui + 1, nxt);
        const char* nA = has_next ? (const char*)g.A + (size_t)nxt.pm * tstep : cA; const char* nB = has_next ? (const char*)g.Bt + (size_t)nxt.pn * tstep : cB;
        for (int t = 0; t < nt; t += 2) {
            const bool last = (t == nt - 2);
            const char* a1 = cA + (size_t)(t + 1) * kstep;
            const char* a2 = last ? nA : cA + (size_t)(t + 2) * kstep; const char* b2 = last ? nB : cB + (size_t)(t + 2) * kstep;
            const char* a3 = a2 + kstep; const char* b3 = b2 + kstep;
            if (last && has_next) S.a_ready(nxt);
            if constexpr (SP2) {
            PG8_LDB(B0, 0, 0); PG8_LDB(B1, 0, 1); PG8_SCHED; PG8_LDA(At, 0, 0); PG8_STAGE(PG8_SA(1, 1), a1 + hstep, voffA);
            PG8_WAIT_V(8); PG8_WAIT_L(0); PG8_BAR; PG8_MMA(0, 0, At, B0); PG8_MMA(0, 1, At, B1); PG8_BAR; PG8_SCHED;
            PG8_LDA(At, 0, 1); PG8_STAGE(PG8_SB(0, 0), b2, voffB); PG8_STAGE(PG8_SB(0, 1), b2 + hstep, voffB); PG8_STAGE(PG8_SA(0, 0), a2, voffA);
            PG8_WAIT_V(8); PG8_WAIT_L(0); PG8_BAR; PG8_MMA(1, 0, At, B0); PG8_MMA(1, 1, At, B1); PG8_BAR; PG8_SCHED;
            PG8_LDB(B0, 1, 0); PG8_LDB(B1, 1, 1); PG8_SCHED; PG8_LDA(At, 1, 0); PG8_STAGE(PG8_SA(0, 1), a2 + hstep, voffA);
            PG8_WAIT_V(8); PG8_WAIT_L(0); PG8_BAR; PG8_MMA(0, 0, At, B0); PG8_MMA(0, 1, At, B1); PG8_BAR; PG8_SCHED;
            PG8_LDA(At, 1, 1); PG8_STAGE(PG8_SB(1, 0), b3, voffB); PG8_STAGE(PG8_SB(1, 1), b3 + hstep, voffB); PG8_STAGE(PG8_SA(1, 0), a3, voffA);
            PG8_WAIT_V(8); PG8_WAIT_L(0); PG8_BAR; PG8_MMA(1, 0, At, B0); PG8_MMA(1, 1, At, B1); PG8_BAR; PG8_SCHED;
            } else {
            PG8_LDB(B0, 0, 0); PG8_SCHED; PG8_LDA(At, 0, 0); PG8_STAGE(PG8_SA(1, 1), a1 + hstep, voffA);
            PG8_WAIT_L(8); PG8_BAR; PG8_WAIT_L(0); PG8_MMA(0, 0, At, B0); PG8_BAR; PG8_SCHED;
            PG8_LDB(B1, 0, 1); PG8_STAGE(PG8_SB(0, 0), b2, voffB);
            PG8_BAR; PG8_WAIT_L(0); PG8_MMA(0, 1, At, B1); PG8_BAR;
            PG8_LDA(At, 0, 1); PG8_STAGE(PG8_SA(0, 0), a2, voffA);
            PG8_BAR; PG8_WAIT_L(0); PG8_MMA(1, 0, At, B0); PG8_BAR; PG8_SCHED;
            PG8_STAGE(PG8_SB(0, 1), b2 + hstep, voffB);
            PG8_WAIT_V(6); PG8_BAR; PG8_MMA(1, 1, At, B1); PG8_BAR;
            PG8_LDB(B0, 1, 0); PG8_SCHED; PG8_LDA(At, 1, 0); PG8_STAGE(PG8_SA(0, 1), a2 + hstep, voffA);
            PG8_WAIT_L(8); PG8_BAR; PG8_WAIT_L(0); PG8_MMA(0, 0, At, B0); PG8_BAR; PG8_SCHED;
            PG8_LDB(B1, 1, 1); PG8_STAGE(PG8_SB(1, 0), b3, voffB);
            PG8_BAR; PG8_WAIT_L(0); PG8_MMA(0, 1, At, B1); PG8_BAR;
            PG8_LDA(At, 1, 1); PG8_STAGE(PG8_SA(1, 0), a3, voffA);
            PG8_BAR; PG8_WAIT_L(0); PG8_MMA(1, 0, At, B0); PG8_BAR; PG8_SCHED;
            PG8_STAGE(PG8_SB(1, 1), b3 + hstep, voffB);
            PG8_WAIT_V(6); PG8_BAR; PG8_MMA(1, 1, At, B1); PG8_BAR;
            }
        }
        if constexpr (ALIGN_EPI) { if (wr == 0) PG8_BAR; }
        if constexpr (!Epi::AFTER_DRAIN) { E(acc, cur, wr, wc, fr, fq); S.done(cur); }
        if (!has_next) break;
#pragma unroll
        for (int a = 0; a < 2; ++a)
#pragma unroll
            for (int b = 0; b < 2; ++b)
#pragma unroll
                for (int m = 0; m < 4; ++m)
#pragma unroll
                    for (int n = 0; n < 2; ++n) acc[a][b][m][n] = (f32x4){0.f, 0.f, 0.f, 0.f};
        cur = nxt; cA = nA; cB = nB; ++ui;
        if constexpr (ALIGN_EPI) { if (wr == 1) PG8_BAR; }
    }
    PG8_WAIT_V(0);
    if constexpr (!ALIGN_EPI) { if (wr == 0) PG8_BAR; }
    PG8_BAR;
    if constexpr (Epi::AFTER_DRAIN) { E.fused(acc, cur, wr, wc, fr, fq, lds, wid, lane); S.done(cur); }
#undef PG8_SA
#undef PG8_SB
#undef PG8_STAGE
#undef PG8_LDA
#undef PG8_LDB
#undef PG8_MMA
#undef PG8_WAIT_V
#undef PG8_WAIT_L
#undef PG8_BAR
#undef PG8_SCHED
}
}
#define XB_TMO      128
#define XB_XCNT(j)  (256  + 64 * (j))
#define XB_XSUB(j)  (1280 + 64 * (j))
#define XB_XGEN(j)  (2304 + 64 * (j))
#define XB_TOP      3328
#define XB_TOPGEN   3392
#define XCD_BAR_WORDS 3456
#define XB_SPIN_CAP (1u << 18)

__device__ __forceinline__ unsigned xb_ld(unsigned* p)              { return __hip_atomic_load(p, __ATOMIC_RELAXED, __HIP_MEMORY_SCOPE_AGENT); }
__device__ __forceinline__ unsigned xb_add(unsigned* p, unsigned v) { return __hip_atomic_fetch_add(p, v, __ATOMIC_RELAXED, __HIP_MEMORY_SCOPE_AGENT); }
__device__ __forceinline__ unsigned xb_xcc_id() { return (unsigned)__builtin_amdgcn_s_getreg((3 << 11) | 20) & 0xFu; }
#define XB_SPIN(cond, bar) do { unsigned _sp = 0; while (cond) { __builtin_amdgcn_s_sleep(1); \
    if ((++_sp & 255u) == 0u) { if (xb_ld(&(bar)[XB_TMO])) break; if (_sp > XB_SPIN_CAP) { atomicAdd(&(bar)[XB_TMO], 1u); break; } } } } while (0)

struct XcdBarrier {
    unsigned* bar; unsigned x;
    volatile LAS unsigned* st;
};

__device__ __forceinline__ XcdBarrier xcd_barrier_post(unsigned* bar, volatile LAS unsigned* st) {
    XcdBarrier b; b.bar = bar; b.x = xb_xcc_id(); b.st = st;
    if (threadIdx.x == 0) (void)xb_add(&bar[XB_XCNT(b.x)], 1u);
    return b;
}
__device__ __forceinline__ void xcd_barrier_complete(unsigned* bar, unsigned x, unsigned& nloc, unsigned& nx) {
    const unsigned G = gridDim.x * gridDim.y * gridDim.z;
    unsigned sum, cnt, mine, sp = 0u;
    for (;;) {
        sum = 0u; cnt = 0u; mine = 0u;
#pragma unroll
        for (unsigned j = 0; j < 16; ++j) { const unsigned c = xb_ld(&bar[XB_XCNT(j)]); sum += c; cnt += (c > 0u) ? 1u : 0u; mine = (j == x) ? c : mine; }
        if (sum == G) break;
        __builtin_amdgcn_s_sleep(1);
        if ((++sp & 255u) == 0u) { if (xb_ld(&bar[XB_TMO])) break; if (sp > XB_SPIN_CAP) { atomicAdd(&bar[XB_TMO], 1u); break; } }
    }
    nloc = mine > 0u ? mine : 1u; nx = cnt > 0u ? cnt : 1u;
}

__device__ __forceinline__ void xcd_barrier(const XcdBarrier& b) {
    asm volatile("s_waitcnt vmcnt(0)" ::: "memory");
    __syncthreads();
    if (threadIdx.x == 0) {
        unsigned* bar = b.bar;
        __builtin_amdgcn_s_waitcnt(0);
        unsigned nloc = b.st[0], nx = b.st[1];
        if (nloc == 0u) { xcd_barrier_complete(bar, b.x, nloc, nx); b.st[0] = nloc; b.st[1] = nx; }
        const unsigned old = xb_add(&bar[XB_XSUB(b.x)], 1u);
        const unsigned gen = old / nloc;
        if (old + 1u == (gen + 1u) * nloc) {
            __builtin_amdgcn_fence(__ATOMIC_RELEASE, "agent");
            asm volatile("s_waitcnt vmcnt(0)" ::: "memory");
            const unsigned og = xb_add(&bar[XB_TOP], 1u);
            const unsigned tg = og / nx;
            if (og + 1u == (tg + 1u) * nx) xb_add(&bar[XB_TOPGEN], 1u);
            else XB_SPIN(xb_ld(&bar[XB_TOPGEN]) == tg, bar);
            __builtin_amdgcn_fence(__ATOMIC_ACQUIRE, "agent");
            xb_add(&bar[XB_XGEN(b.x)], 1u);
            asm volatile("s_waitcnt vmcnt(0)" ::: "memory");
        } else {
            XB_SPIN(xb_ld(&bar[XB_XGEN(b.x)]) == gen, bar);
            __builtin_amdgcn_fence(__ATOMIC_ACQUIRE, "agent");
            asm volatile("s_waitcnt vmcnt(0)" ::: "memory");
        }
    }
    __syncthreads();
}

typedef GAS unsigned gu32;
#define RLX_AGENT __ATOMIC_RELAXED, __HIP_MEMORY_SCOPE_AGENT
#define LDS_WAIT() asm volatile("s_waitcnt lgkmcnt(0)" ::: "memory")
#define VM_WAIT() asm volatile("s_waitcnt vmcnt(0)" ::: "memory")
constexpr int NWAVES = 8;

struct Frame {
    LAS unsigned char* lds;
    unsigned char* ws; float* out;
    const void* const* in;
    int tid, lane, wave, vcu, G;
};
struct Args { const void* in[26]; float* out; unsigned char* ws; int ph_lo, ph_hi; };

enum { I_XP = 0, I_XS, I_MEMP, I_CK, I_CV, I_CIK, I_STATE, I_CMK, I_CMV, I_PT, I_GMIX, I_WIN, I_GNRET, I_WRO, I_WDO, I_WO, I_GMEM, I_GMEMKV, I_WMQ, I_WMK, I_WMV, I_WMO, I_GMLP, I_WUP, I_WDN, I_GFINAL };

__device__ __forceinline__ void p0_transpose_item(const float* W, int ldw, int k0, int rc, const float* g, bf16_t* WT, int ldt, int vrow0, LAS float* scr, int lane) {
#pragma unroll 8
    for (int i = 0; i < 32; ++i) { const int kk = 2 * i + (lane >> 5); float v = 0.f; if (rc >= 0) v = W[(size_t)(k0 + kk) * ldw + rc]; if (g) v *= g[k0 + kk]; scr[kk * 33 + (lane & 31)] = v; }
    LDS_WAIT(); asm volatile("" ::: "memory");
    const int c = lane & 7;
#pragma unroll
    for (int j = 0; j < 4; ++j) { const int n = (lane >> 3) + 8 * j; const LAS float* s = scr + (8 * c) * 33 + n;
        u32x4 o; o.x = pk2(s[0 * 33], s[1 * 33]); o.y = pk2(s[2 * 33], s[3 * 33]); o.z = pk2(s[4 * 33], s[5 * 33]); o.w = pk2(s[6 * 33], s[7 * 33]);
        *(GAS u32x4*)(WT + (size_t)(vrow0 + n) * ldt + k0 + 8 * c) = o; }
    LDS_WAIT(); asm volatile("" ::: "memory");
}
__device__ __forceinline__ void rms_row_to_bf16(const float* xrow, const float* g, bf16_t* orow, int lane) {
    const GAS f32x4* xr = (const GAS f32x4*)xrow + lane; const GAS f32x4* gr = (const GAS f32x4*)g + lane;
    f32x4 v[8]; float s = 0.f;
#pragma unroll
    for (int j = 0; j < 8; ++j) { v[j] = xr[64 * j]; s += (v[j].x * v[j].x + v[j].y * v[j].y) + (v[j].z * v[j].z + v[j].w * v[j].w); }
    const float rstd = 1.0f / sqrtf(wave_sum(s) * (1.0f / DM) + EPS);
    GAS u32x2* o8 = (GAS u32x2*)orow + lane;
#pragma unroll
    for (int j = 0; j < 8; ++j) { const f32x4 gg = gr[64 * j]; u32x2 w; w.x = pk2(v[j].x * rstd * gg.x, v[j].y * rstd * gg.y); w.y = pk2(v[j].z * rstd * gg.z, v[j].w * rstd * gg.w); o8[64 * j] = w; }
}
__device__ __forceinline__ void p0_prologue(Frame& F, const Args& A) {
    LAS float* scr = (LAS float*)(F.lds + F.wave * 16384);
    const int gw = F.vcu * NWAVES + F.wave, NGW = F.G * NWAVES, lane = F.lane;
    unsigned char* ws = F.ws;
    constexpr int I_IN = 32 * (12032 / 32);
    constexpr int I_RO = 16 * 64, I_DOO = 16 * 64, I_O = 32 * 64, I_MQ = 32 * 16, I_MO = 8 * 64, I_UP = 32 * 256, I_DN = 128 * 64;
    constexpr int NITEMS = I_IN + I_RO + I_DOO + I_O + I_MQ + I_MO + I_UP + I_DN;
    for (int it = gw; it < NITEMS; it += NGW) {
        int r = it;
        if (r < I_IN) { const int vg = r >> 5, kb = r & 31, v0 = vg * 32;
            if (v0 < NV1) { const int rc = win_real_col(v0 + (lane & 31)); p0_transpose_item((const float*)A.in[I_WIN], NIN, kb * 64, rc, nullptr, (bf16_t*)(ws + WS_WT1), DM, v0, scr, lane); }
            else if (v0 < NV1 + 512) p0_transpose_item((const float*)A.in[I_WMK], MEMW, kb * 64, v0 - NV1 + (lane & 31), nullptr, (bf16_t*)(ws + WS_WT1), DM, v0, scr, lane);
            else p0_transpose_item((const float*)A.in[I_WMV], MEMW, kb * 64, v0 - NV1 - 512 + (lane & 31), nullptr, (bf16_t*)(ws + WS_WT1), DM, v0, scr, lane);
            continue; } r -= I_IN;
        if (r < I_RO) { const int vg = r >> 4, kb = r & 15; p0_transpose_item((const float*)A.in[I_WRO], DM, kb * 64, vg * 32 + (lane & 31), nullptr, (bf16_t*)(ws + WS_WRO), 1024, vg * 32, scr, lane); continue; } r -= I_RO;
        if (r < I_DOO) { const int vg = r >> 4, kb = r & 15; p0_transpose_item((const float*)A.in[I_WDO], DM, kb * 64, vg * 32 + (lane & 31), nullptr, (bf16_t*)(ws + WS_WDO), 1024, vg * 32, scr, lane); continue; } r -= I_DOO;
        if (r < I_O) { const int vg = r >> 5, kb = r & 31; p0_transpose_item((const float*)A.in[I_WO], DM, kb * 64, vg * 32 + (lane & 31), nullptr, (bf16_t*)(ws + WS_WO), DM, vg * 32, scr, lane); continue; } r -= I_O;
        if (r < I_MQ) { const int vg = r >> 5, kb = r & 31; p0_transpose_item((const float*)A.in[I_WMQ], MEMW, kb * 64, vg * 32 + (lane & 31), (const float*)A.in[I_GMEM], (bf16_t*)(ws + WS_WMQ), DM, vg * 32, scr, lane); continue; } r -= I_MQ;
        if (r < I_MO) { const int vg = r >> 3, kb = r & 7; p0_transpose_item((const float*)A.in[I_WMO], DM, kb * 64, vg * 32 + (lane & 31), nullptr, (bf16_t*)(ws + WS_WMO), MEMW, vg * 32, scr, lane); continue; } r -= I_MO;
        if (r < I_UP) { const int vg = r >> 5, kb = r & 31; p0_transpose_item((const float*)A.in[I_WUP], DFF, kb * 64, vg * 32 + (lane & 31), (const float*)A.in[I_GMLP], (bf16_t*)(ws + WS_WUP), DM, vg * 32, scr, lane); continue; } r -= I_UP;
        { const int vg = r >> 7, kb = r & 127; p0_transpose_item((const float*)A.in[I_WDN], DM, kb * 64, vg * 32 + (lane & 31), nullptr, (bf16_t*)(ws + WS_WDN), DFF, vg * 32, scr, lane); }
    }
    for (int m = gw; m < MP + 512 + MS; m += NGW) {
        if (m < MP) rms_row_to_bf16((const float*)A.in[I_XP] + (size_t)m * DM, (const float*)A.in[I_GMIX], (bf16_t*)(ws + WS_XN) + (size_t)m * DM, lane);
        else if (m < MP + 512) rms_row_to_bf16((const float*)A.in[I_MEMP] + (size_t)(m - MP) * DM, (const float*)A.in[I_GMEMKV], (bf16_t*)(ws + WS_XN) + (size_t)m * DM, lane);
        else rms_row_to_bf16((const float*)A.in[I_XS] + (size_t)(m - MP - 512) * DM, (const float*)A.in[I_GMIX], (bf16_t*)(ws + WS_SMP + SM_XN) + (size_t)(m - MP - 512) * DM, lane);
    }
    {
        const int gt = F.vcu * (NWAVES * 64) + F.tid, NGT = F.G * NWAVES * 64;
        float* c64 = (float*)(ws + WS_TAB + TAB_COS64); float* s64 = (float*)(ws + WS_TAB + TAB_SIN64);
        float* c16 = (float*)(ws + WS_TAB + TAB_COS16); float* s16 = (float*)(ws + WS_TAB + TAB_SIN16);
        float* c8 = (float*)(ws + WS_TAB + TAB_COS8); float* s8 = (float*)(ws + WS_TAB + TAB_SIN8);
        for (int e = gt; e < NTPOS * 88; e += NGT) {
            const int tp = e / 88, i = e % 88; const float pos = (float)(tp < SEQ ? tp : PAST + (tp - SEQ));
            float inv; float* cd; float* sd;
            if (i < 64) { inv = powf(10000.0f, -(float)i / 64.0f); cd = c64 + tp * 64 + i; sd = s64 + tp * 64 + i; }
            else if (i < 80) { inv = powf(500000.0f, -(float)(i - 64) / 16.0f); cd = c16 + tp * 16 + (i - 64); sd = s16 + tp * 16 + (i - 64); }
            else { inv = powf(500000.0f, -(float)(i - 80) / 8.0f); cd = c8 + tp * 8 + (i - 80); sd = s8 + tp * 8 + (i - 80); }
            const float ang = pos * inv; float sn, cs; sincosf(ang, &sn, &cs); *cd = cs; *sd = sn;
        }
        const float* cmk = (const float*)A.in[I_CMK]; const float* cmv = (const float*)A.in[I_CMV];
        bf16_t* kb = (bf16_t*)(ws + WS_MEMKB) + 2 * 256 * 512; bf16_t* vb = (bf16_t*)(ws + WS_MEMVB) + 2 * 256 * 512;
        for (int e = gt; e < 2 * 8 * 256 * 512 / 4; e += NGT) {
            const int half = 8 * 256 * 512 / 4; const bool isv = e >= half; const int j = isv ? e - half : e;
            const f32x4 x = *((const GAS f32x4*)(isv ? cmv : cmk) + j); u32x2 w; w.x = pk2(x.x, x.y); w.y = pk2(x.z, x.w);
            *((GAS u32x2*)(isv ? vb : kb) + j) = w;
        }
    }
}
struct OrderX : pg8::StaticOrder {
    int nextra, xm0, xn0, xn;
    __device__ void initx(int M, int N, int G_, int c_, int nextra_, int xm0_, int xn0_, int xn_) { init(M, N, G_, c_); nextra = nextra_; xm0 = xm0_; xn0 = xn0_; xn = xn_; }
    __device__ bool next(int i, pg8::Unit& u) const {
        const long L = (long)i * G + c;
        if (L < nwg) return pg8::StaticOrder::next(i, u);
        const int e = (int)(L - nwg); if (e >= nextra) return false;
        u.pm = xm0 + e / xn; u.pn = xn0 + e % xn; return true;
    }
};
struct OrderDual : pg8::StaticOrder {
    __device__ bool next(int i, pg8::Unit& u) const {
        if (i >= 2) return false; if (!pg8::StaticOrder::next(0, u)) return false;
        if (i == 1) { u.pm += 32; u.pn += 8; } return true;
    }
};

__device__ __forceinline__ f32x16 skinny_partial(const bf16_t* A, int lda, const bf16_t* Wt, int K, int nb, int wave, int lane) {
    const int r32 = lane & 31, hi = lane >> 5, kw = K / 8;
    const bf16_t* ap = A + (size_t)r32 * lda + wave * kw + 8 * hi; const bf16_t* bp = Wt + (size_t)(nb * 32 + r32) * K + wave * kw + 8 * hi;
    f32x16 acc = {};
    for (int k = 0; k < kw; k += 64) {
        bf16x8 a[4], b[4];
#pragma unroll
        for (int i = 0; i < 4; ++i) { a[i] = *(const GAS bf16x8*)(ap + k + 16 * i); b[i] = *(const GAS bf16x8*)(bp + k + 16 * i); }
#pragma unroll
        for (int i = 0; i < 4; ++i) acc = __builtin_amdgcn_mfma_f32_32x32x16_bf16(a[i], b[i], acc, 0, 0, 0);
    }
    return acc;
}
__device__ __forceinline__ void skinny_reduce(const f32x16& acc, LAS float* red, int wave, int lane, int tid, float& v1, float& v2) {
    const int r32 = lane & 31, hi = lane >> 5;
    __syncthreads();
#pragma unroll
    for (int r = 0; r < 16; ++r) red[wave * 1024 + crow(r, hi) * 32 + r32] = acc[r];
    __syncthreads();
    const int row = tid >> 4, c = tid & 15; v1 = 0.f; v2 = 0.f;
#pragma unroll
    for (int w = 0; w < 8; ++w) { v1 += red[w * 1024 + row * 32 + c]; v2 += red[w * 1024 + row * 32 + 16 + c]; }
}
__device__ __forceinline__ float sum16(float v) { v += __shfl_xor(v, 1); v += __shfl_xor(v, 2); v += __shfl_xor(v, 4); v += __shfl_xor(v, 8); return v; }

#define PB(off) ((bf16_t*)(ws + (off)))
#define PF(off) ((float*)(ws + (off)))
#define TABF(off) ((const float*)(ws + WS_TAB + (off)))
__device__ __forceinline__ void st_bf4(bf16_t* p, f32x4 v) { u32x2 w; w.x = pk2(v.x, v.y); w.y = pk2(v.z, v.w); *(GAS u32x2*)p = w; }

struct EpiIn {
    static constexpr bool PERM = false, AFTER_DRAIN = false;
    unsigned char* ws; float* out;
    __device__ __forceinline__ void operator()(const f32x4 (&acc)[2][2][4][2], const pg8::Unit& u, int wr, int wc, int fr, int fq) const {
        const int pn = u.pn; const int rowb = u.pm * 256 + wr * 64 + fr;
        if (pn < 8) {
            const bool isk = pn >= 4; bf16_t* dst = PB(isk ? WS_RK : WS_RQ);
#pragma unroll
            for (int bj = 0; bj < 2; ++bj) { const int head = (pn & 3) * 2 + bj; const float l2 = lg2g(head);
#pragma unroll
                for (int ai = 0; ai < 2; ++ai)
#pragma unroll
                    for (int m = 0; m < 4; ++m) { const int row = rowb + ai * 128 + m * 16, tp = row & (SEQ - 1), ci = row & 127;
                        const f32x4 cs = *(const GAS f32x4*)(TABF(TAB_COS64) + tp * 64 + 16 * wc + 4 * fq), sn = *(const GAS f32x4*)(TABF(TAB_SIN64) + tp * 64 + 16 * wc + 4 * fq);
                        const float dec = isk ? exp2f(-(float)(ci + 1) * l2) * QK_SCALE : exp2f((float)(ci + 1) * l2);
                        const f32x4 x1 = acc[ai][bj][m][0], x2 = acc[ai][bj][m][1];
                        bf16_t* o = dst + (size_t)row * 1024 + head * 128 + 16 * wc + 4 * fq;
                        st_bf4(o, (x1 * cs - x2 * sn) * dec); st_bf4(o + 64, (x2 * cs + x1 * sn) * dec); } }
        } else if (pn < 16) {
            const bool isg = pn >= 12; bf16_t* dst = PB(isg ? WS_RG : WS_RV); const int cb = (pn & 3) * 256 + 32 * wc + 4 * fq;
#pragma unroll
            for (int ai = 0; ai < 2; ++ai)
#pragma unroll
                for (int m = 0; m < 4; ++m) { const int row = rowb + ai * 128 + m * 16;
#pragma unroll
                    for (int bj = 0; bj < 2; ++bj)
#pragma unroll
                        for (int n = 0; n < 2; ++n) { f32x4 v = acc[ai][bj][m][n]; if (isg) { v.x = siluf_(v.x); v.y = siluf_(v.y); v.z = siluf_(v.z); v.w = siluf_(v.w); }
                            st_bf4(dst + (size_t)row * 1024 + cb + bj * 128 + 16 * n, v); } }
        } else if (pn < 22) {
            const bool isq = pn < 20, isv = pn == 21; bf16_t* dst = PB(isq ? WS_DQ : (isv ? WS_DV : WS_DK)); const int ld = isq ? 1024 : 256; float* fo = isq ? nullptr : out + (isv ? O_VP : O_KP);
            const int cb = (isq ? (pn - 16) * 256 : 0) + 32 * wc + 4 * fq; const bool rot = (wc == 0) && !isv;
#pragma unroll
            for (int ai = 0; ai < 2; ++ai)
#pragma unroll
                for (int m = 0; m < 4; ++m) { const int row = rowb + ai * 128 + m * 16, tp = row & (SEQ - 1);
                    f32x4 cs = {1.f, 1.f, 1.f, 1.f}, sn = {0.f, 0.f, 0.f, 0.f};
                    if (rot) { cs = *(const GAS f32x4*)(TABF(TAB_COS16) + tp * 16 + 4 * fq); sn = *(const GAS f32x4*)(TABF(TAB_SIN16) + tp * 16 + 4 * fq); }
#pragma unroll
                    for (int bj = 0; bj < 2; ++bj) { const f32x4 x1 = acc[ai][bj][m][0], x2 = acc[ai][bj][m][1];
                        const f32x4 o1 = x1 * cs - x2 * sn, o2 = x2 * cs + x1 * sn;
                        const size_t off = (size_t)row * ld + cb + bj * 128;
                        st_bf4(dst + off, o1); st_bf4(dst + off + 16, o2);
                        if (fo) { *(GAS f32x4*)(fo + off) = o1; *(GAS f32x4*)(fo + off + 16) = o2; } } }
        } else if (pn < 26) {
            const int hb = (pn - 22) * 4 + (wc >> 1);
            const bool low = (wc & 1) == 0; const bool rot = low && fq < 2; const int fqc = fq & 1;
#pragma unroll
            for (int ai = 0; ai < 2; ++ai)
#pragma unroll
                for (int m = 0; m < 4; ++m) { const int row = rowb + ai * 128 + m * 16, tp = row & (SEQ - 1);
                    f32x4 cs = {1.f, 1.f, 1.f, 1.f}, sn = {0.f, 0.f, 0.f, 0.f};
                    if (rot) { cs = *(const GAS f32x4*)(TABF(TAB_COS8) + tp * 8 + 4 * fqc); sn = *(const GAS f32x4*)(TABF(TAB_SIN8) + tp * 8 + 4 * fqc); }
#pragma unroll
                    for (int bj = 0; bj < 2; ++bj) { const f32x4 x1 = acc[ai][bj][m][0], x2 = acc[ai][bj][m][1];
                        const f32x4 o1 = x1 * cs - x2 * sn, o2 = x2 * cs + x1 * sn;
                        const int e0 = low ? (fq < 2 ? 4 * fq : 16 + 4 * (fq - 2)) : 32 + 4 * fq, e1 = low ? e0 + 8 : e0 + 16;
                        bf16_t* o = PB(WS_IQ) + (size_t)row * 1024 + (hb + 2 * bj) * 64;
                        st_bf4(o + e0, o1); st_bf4(o + e1, o2); } }
        } else if (pn == 26) {
            if (wc < 2) { const bool low = wc == 0; const bool rot = low && fq < 2; const int fqc = fq & 1;
#pragma unroll
                for (int ai = 0; ai < 2; ++ai)
#pragma unroll
                    for (int m = 0; m < 4; ++m) { const int row = rowb + ai * 128 + m * 16, tp = row & (SEQ - 1);
                        f32x4 cs = {1.f, 1.f, 1.f, 1.f}, sn = {0.f, 0.f, 0.f, 0.f};
                        if (rot) { cs = *(const GAS f32x4*)(TABF(TAB_COS8) + tp * 8 + 4 * fqc); sn = *(const GAS f32x4*)(TABF(TAB_SIN8) + tp * 8 + 4 * fqc); }
                        const f32x4 x1 = acc[ai][0][m][0], x2 = acc[ai][0][m][1];
                        const f32x4 o1 = x1 * cs - x2 * sn, o2 = x2 * cs + x1 * sn;
                        const int e0 = low ? (fq < 2 ? 4 * fq : 16 + 4 * (fq - 2)) : 32 + 4 * fq, e1 = low ? e0 + 8 : e0 + 16;
                        st_bf4(PB(WS_IK) + (size_t)row * 64 + e0, o1); st_bf4(PB(WS_IK) + (size_t)row * 64 + e1, o2);
                        *(GAS f32x4*)(out + O_IKP + (size_t)row * 64 + e0) = o1; *(GAS f32x4*)(out + O_IKP + (size_t)row * 64 + e1) = o2; }
            } else if (wc == 2) {
#pragma unroll
                for (int ai = 0; ai < 2; ++ai)
#pragma unroll
                    for (int m = 0; m < 4; ++m) { const int row = rowb + ai * 128 + m * 16; *(GAS f32x4*)(PF(WS_IW) + (size_t)row * 16 + 4 * fq) = acc[ai][0][m][0]; }
            }
        } else if (pn < 43) {
            const bool isb = pn >= 35; bf16_t* dst = PB(isb ? WS_GB : WS_GA); const int cb = (pn - (isb ? 35 : 27)) * 256 + 32 * wc + 4 * fq;
#pragma unroll
            for (int ai = 0; ai < 2; ++ai)
#pragma unroll
                for (int m = 0; m < 4; ++m) { const int row = rowb + ai * 128 + m * 16;
#pragma unroll
                    for (int bj = 0; bj < 2; ++bj)
#pragma unroll
                        for (int n = 0; n < 2; ++n) { f32x4 v = acc[ai][bj][m][n]; v.x = sigmoidf_(v.x); v.y = sigmoidf_(v.y); v.z = sigmoidf_(v.z); v.w = sigmoidf_(v.w);
                            st_bf4(dst + (size_t)row * 2048 + cb + bj * 128 + 16 * n, v); } }
        } else {
            const bool isv = pn >= 45; float* fo = out + (isv ? O_MV : O_MK); bf16_t* bo = PB(isv ? WS_MEMVB : WS_MEMKB); const int cb = ((pn - 43) & 1) * 256 + 32 * wc + 4 * fq;
#pragma unroll
            for (int ai = 0; ai < 2; ++ai)
#pragma unroll
                for (int m = 0; m < 4; ++m) { const int row = rowb - MP + ai * 128 + m * 16;
#pragma unroll
                    for (int bj = 0; bj < 2; ++bj)
#pragma unroll
                        for (int n = 0; n < 2; ++n) { const f32x4 v = acc[ai][bj][m][n]; const size_t off = (size_t)row * 512 + cb + bj * 128 + 16 * n;
                            *(GAS f32x4*)(fo + off) = v; st_bf4(bo + off, v); } }
        }
    }
};

__device__ __forceinline__ void st1(bf16_t* p, float v) { *(GAS bf16_t*)p = (bf16_t)f2bf(v); }
__device__ __forceinline__ void epi_in_sample(unsigned char* ws, float* out, int row, int nb, int c, float v1, float v2) {
    const int pn = nb >> 3, bj = (nb >> 2) & 1, wc = nb & 3, t = row & 3, tp = SEQ + t, fq = c >> 2, j = c & 3;
    if (pn < 8) { const bool isk = pn >= 4; const int head = (pn & 3) * 2 + bj, i = 16 * wc + c; const float l2 = lg2g(head);
        const float cs = TABF(TAB_COS64)[tp * 64 + i], sn = TABF(TAB_SIN64)[tp * 64 + i], dec = isk ? exp2f(-(float)(t + 1) * l2) * QK_SCALE : exp2f((float)(t + 1) * l2);
        bf16_t* o = PB(WS_SMP + (isk ? SM_RK : SM_RQ)) + (size_t)row * 1024 + head * 128 + i;
        st1(o, (v1 * cs - v2 * sn) * dec); st1(o + 64, (v2 * cs + v1 * sn) * dec);
    } else if (pn < 16) { const bool isg = pn >= 12; bf16_t* o = PB(WS_SMP + (isg ? SM_RG : SM_RV)) + (size_t)row * 1024 + (pn & 3) * 256 + bj * 128 + 32 * wc + c;
        st1(o, isg ? siluf_(v1) : v1); st1(o + 16, isg ? siluf_(v2) : v2);
    } else if (pn < 22) { const bool isq = pn < 20, isv = pn == 21; const int ld = isq ? 1024 : 256; const size_t off = (size_t)row * ld + (isq ? (pn - 16) * 256 : 0) + bj * 128 + 32 * wc + c;
        float cs = 1.f, sn = 0.f; if (wc == 0 && !isv) { cs = TABF(TAB_COS16)[tp * 16 + c]; sn = TABF(TAB_SIN16)[tp * 16 + c]; }
        const float o1 = v1 * cs - v2 * sn, o2 = v2 * cs + v1 * sn; bf16_t* dst = PB(WS_SMP + (isq ? SM_DQ : (isv ? SM_DV : SM_DK)));
        st1(dst + off, o1); st1(dst + off + 16, o2);
        if (!isq) { float* fo = out + (isv ? O_VS : O_KS); fo[off] = o1; fo[off + 16] = o2; }
    } else if (pn < 27) {
        if (pn == 26 && (bj == 1 || wc > 2)) return;
        if (pn == 26 && wc == 2) { PF(WS_SMP + SM_IW)[row * 16 + c] = v1; return; }
        const bool low = (wc & 1) == 0; const bool rot = low && fq < 2;
        float cs = 1.f, sn = 0.f; if (rot) { cs = TABF(TAB_COS8)[tp * 8 + c]; sn = TABF(TAB_SIN8)[tp * 8 + c]; }
        const float o1 = v1 * cs - v2 * sn, o2 = v2 * cs + v1 * sn;
        const int e0 = (low ? (fq < 2 ? 4 * fq : 16 + 4 * (fq - 2)) : 32 + 4 * fq) + j, e1 = low ? e0 + 8 : e0 + 16;
        if (pn < 26) { bf16_t* o = PB(WS_SMP + SM_IQ) + (size_t)row * 1024 + ((pn - 22) * 4 + 2 * bj + (wc >> 1)) * 64; st1(o + e0, o1); st1(o + e1, o2); }
        else { st1(PB(WS_SMP + SM_IK) + row * 64 + e0, o1); st1(PB(WS_SMP + SM_IK) + row * 64 + e1, o2); out[O_IKS + row * 64 + e0] = o1; out[O_IKS + row * 64 + e1] = o2; }
    } else { const bool isb = pn >= 35; bf16_t* o = PB(WS_SMP + (isb ? SM_GB : SM_GA)) + (size_t)row * 2048 + (pn - (isb ? 35 : 27)) * 256 + bj * 128 + 32 * wc + c;
        st1(o, sigmoidf_(v1)); st1(o + 16, sigmoidf_(v2)); }
}
__device__ __forceinline__ void d1_unit(Frame& F, int b, int qb, int kb) {
    const int lane = F.lane, wave = F.wave, r32 = lane & 31, hi = lane >> 5, qs = wave & 3, kh = wave >> 2;
    const bf16_t* IQ = (const bf16_t*)(F.ws + WS_IQ); const bf16_t* IK = (const bf16_t*)(F.ws + WS_IK); const float* IW = (const float*)(F.ws + WS_IW);
    float* SC = (float*)(F.ws + WS_SCORES);
    LAS float* wl = (LAS float*)(F.lds) + wave * 512;
    const int q0 = b * SEQ + qb * 128 + qs * 32, k0 = b * SEQ + kb * 128 + kh * 64;
    __syncthreads();
    {
        const GAS f32x4* src = (const GAS f32x4*)(IW + (size_t)q0 * 16) + lane * 2;
        const f32x4 a = src[0], c = src[1]; const int q = lane >> 1, h0 = (lane & 1) * 8;
        wl[(h0 + 0) * 32 + q] = a.x; wl[(h0 + 1) * 32 + q] = a.y; wl[(h0 + 2) * 32 + q] = a.z; wl[(h0 + 3) * 32 + q] = a.w;
        wl[(h0 + 4) * 32 + q] = c.x; wl[(h0 + 5) * 32 + q] = c.y; wl[(h0 + 6) * 32 + q] = c.z; wl[(h0 + 7) * 32 + q] = c.w;
    }
    bf16x8 bk[2][4];
#pragma unroll
    for (int cb = 0; cb < 2; ++cb)
#pragma unroll
        for (int ks = 0; ks < 4; ++ks) bk[cb][ks] = *(const GAS bf16x8*)(IK + (size_t)(k0 + cb * 32 + r32) * 64 + ks * 16 + 8 * hi);
    const bf16_t* aq = IQ + (size_t)(q0 + r32) * 1024 + 8 * hi;
    bf16x8 an[4];
#pragma unroll
    for (int ks = 0; ks < 4; ++ks) an[ks] = *(const GAS bf16x8*)(aq + ks * 16);
    f32x16 s0 = {}, s1 = {};
    LDS_WAIT();
    for (int h = 0; h < 16; ++h) {
        bf16x8 a[4];
#pragma unroll
        for (int ks = 0; ks < 4; ++ks) a[ks] = an[ks];
        if (h < 15) {
#pragma unroll
            for (int ks = 0; ks < 4; ++ks) an[ks] = *(const GAS bf16x8*)(aq + (h + 1) * 64 + ks * 16);
        }
        f32x16 d0 = {}, d1 = {};
#pragma unroll
        for (int ks = 0; ks < 4; ++ks) { d0 = __builtin_amdgcn_mfma_f32_32x32x16_bf16(a[ks], bk[0][ks], d0, 0, 0, 0); d1 = __builtin_amdgcn_mfma_f32_32x32x16_bf16(a[ks], bk[1][ks], d1, 0, 0, 0); }
        f32x4 wv[4];
#pragma unroll
        for (int g = 0; g < 4; ++g) wv[g] = *(const LAS f32x4*)(wl + h * 32 + 8 * g + 4 * hi);
#pragma unroll
        for (int r = 0; r < 16; ++r) { const float w = wv[r >> 2][r & 3]; s0[r] = fmaf(fmaxf(d0[r], 0.f), w, s0[r]); s1[r] = fmaf(fmaxf(d1[r], 0.f), w, s1[r]); }
    }
#pragma unroll
    for (int r = 0; r < 16; ++r) { float* o = SC + (size_t)(q0 + crow(r, hi)) * SEQ + (kb * 128 + kh * 64 + r32); o[0] = s0[r]; o[32] = s1[r]; }
}

typedef short v4i16_t __attribute__((ext_vector_type(4)));
__device__ __forceinline__ bf16x8 tr_frag(const LAS bf16_t* T, int ld, int k0, int c0, int lane) {
    const LAS bf16_t* p = T + (k0 + 8 * (lane >> 5) + ((lane & 15) >> 2)) * ld + c0 + 16 * ((lane >> 4) & 1) + 4 * (lane & 3);
    const v4i16_t lo = __builtin_amdgcn_ds_read_tr16_b64_v4i16((LAS v4i16_t*)p);
    const v4i16_t hh = __builtin_amdgcn_ds_read_tr16_b64_v4i16((LAS v4i16_t*)(p + 4 * ld));
    return (bf16x8){lo[0], lo[1], lo[2], lo[3], hh[0], hh[1], hh[2], hh[3]};
}
constexpr int TLD = 160;
__device__ __forceinline__ void stage_tile128(const bf16_t* g, int gld, LAS bf16_t* T, int tid) {
    const int row = tid >> 2, q = tid & 3;
    const GAS u32x4* src = (const GAS u32x4*)(g + (size_t)row * gld + q * 32);
    const u32x4 a = src[0], b = src[1], c = src[2], d = src[3];
    LAS u32x4* dst = (LAS u32x4*)(T + row * TLD + q * 32);
    dst[0] = a; dst[1] = b; dst[2] = c; dst[3] = d;
}

__device__ __forceinline__ void r1_unit(Frame& F, int bh, int n) {
    const int lane = F.lane, wave = F.wave, r32 = lane & 31, hi = lane >> 5, b = bh >> 3, h = bh & 7;
    LAS bf16_t* Vt = (LAS bf16_t*)F.lds; LAS bf16_t* Kt = Vt + 128 * TLD;
    const size_t row0 = (size_t)b * SEQ + n * 128;
    __syncthreads();
    stage_tile128((const bf16_t*)(F.ws + WS_RV) + row0 * 1024 + h * 128, 1024, Vt, F.tid);
    stage_tile128((const bf16_t*)(F.ws + WS_RK) + row0 * 1024 + h * 128, 1024, Kt, F.tid);
    __syncthreads();
    const int dvb = wave & 3, dkh = wave >> 2;
    f32x16 acc0 = {}, acc1 = {};
#pragma unroll
    for (int ks = 0; ks < 8; ++ks) {
        const bf16x8 a = tr_frag(Vt, TLD, 16 * ks, 32 * dvb, lane);
        const bf16x8 b0 = tr_frag(Kt, TLD, 16 * ks, 64 * dkh, lane), b1 = tr_frag(Kt, TLD, 16 * ks, 64 * dkh + 32, lane);
        acc0 = __builtin_amdgcn_mfma_f32_32x32x16_bf16(a, b0, acc0, 0, 0, 0); acc1 = __builtin_amdgcn_mfma_f32_32x32x16_bf16(a, b1, acc1, 0, 0, 0);
    }
    float* o = (float*)(F.ws + WS_KVC) + ((size_t)bh * 32 + n) * 16384;
#pragma unroll
    for (int r = 0; r < 16; ++r) { float* p = o + (32 * dvb + crow(r, hi)) * 128 + 64 * dkh + r32; p[0] = acc0[r]; p[32] = acc1[r]; }
}

__device__ __forceinline__ void s1_unit(Frame& F, const Args& A, int b, int c) {
    const int lane = F.lane, wave = F.wave, r32 = lane & 31, hi = lane >> 5;
    const bf16_t* IQ = (const bf16_t*)(F.ws + WS_SMP + SM_IQ); const float* IW = (const float*)(F.ws + WS_SMP + SM_IW);
    const float* CIK = (const float*)A.in[I_CIK]; const int* PT = (const int*)A.in[I_PT];
    float* SS = (float*)(F.ws + WS_SMP + SM_SCORE);
    const int s0 = c * 512 + wave * 64;
    const int page = PT[b * 128 + (s0 >> 7)];
    const float* kbase = CIK + ((size_t)page * 128 + (s0 & 127)) * 64;
    bf16x8 bk[2][4];
#pragma unroll
    for (int cb = 0; cb < 2; ++cb)
#pragma unroll
        for (int ks = 0; ks < 4; ++ks) { const GAS f32x4* p = (const GAS f32x4*)(kbase + (size_t)(cb * 32 + r32) * 64 + ks * 16 + 8 * hi); const f32x4 x = p[0], y = p[1];
            u32x4 w; w.x = pk2(x.x, x.y); w.y = pk2(x.z, x.w); w.z = pk2(y.x, y.y); w.w = pk2(y.z, y.w); bk[cb][ks] = __builtin_bit_cast(bf16x8, w); }
#pragma unroll
    for (int rb = 0; rb < 2; ++rb) {
        const bf16_t* ap = IQ + (size_t)(b * 4 + 2 * rb + (r32 >> 4)) * 1024 + (r32 & 15) * 64 + 8 * hi;
        f32x16 d0 = {}, d1 = {};
#pragma unroll
        for (int ks = 0; ks < 4; ++ks) { const bf16x8 a = *(const GAS bf16x8*)(ap + ks * 16);
            d0 = __builtin_amdgcn_mfma_f32_32x32x16_bf16(a, bk[0][ks], d0, 0, 0, 0); d1 = __builtin_amdgcn_mfma_f32_32x32x16_bf16(a, bk[1][ks], d1, 0, 0, 0); }
        float p00 = 0.f, p01 = 0.f, p10 = 0.f, p11 = 0.f;
#pragma unroll
        for (int r = 0; r < 16; ++r) { const int row = crow(r, hi), tl = row >> 4, h = row & 15; const float w = IW[(b * 4 + 2 * rb + tl) * 16 + h];
            const float e0 = fmaxf(d0[r], 0.f) * w, e1 = fmaxf(d1[r], 0.f) * w; if (r < 8) { p00 += e0; p10 += e1; } else { p01 += e0; p11 += e1; } }
        p00 += __shfl_xor(p00, 32); p01 += __shfl_xor(p01, 32); p10 += __shfl_xor(p10, 32); p11 += __shfl_xor(p11, 32);
        float* o = SS + (size_t)(b * 4 + 2 * rb + hi) * SLEN + s0 + r32;
        o[0] = hi ? p01 : p00; o[32] = hi ? p11 : p10;
    }
}
__device__ __forceinline__ void s1_tail(Frame& F, int b) {
    const int lane = F.lane; const bf16_t* IQ = (const bf16_t*)(F.ws + WS_SMP + SM_IQ); const bf16_t* IK = (const bf16_t*)(F.ws + WS_SMP + SM_IK);
    const float* IW = (const float*)(F.ws + WS_SMP + SM_IW); float* SS = (float*)(F.ws + WS_SMP + SM_SCORE);
    const int t = lane >> 4, tk = (lane >> 2) & 3, hq = lane & 3; float sc = 0.f;
    for (int hh = 0; hh < 4; ++hh) { const int h = hq * 4 + hh; float d = 0.f;
        for (int e = 0; e < 64; ++e) d += bf2f(IQ[(size_t)(b * 4 + t) * 1024 + h * 64 + e]) * bf2f(IK[(b * 4 + tk) * 64 + e]);
        sc += fmaxf(d, 0.f) * IW[(b * 4 + t) * 16 + h]; }
    sc += __shfl_xor(sc, 1); sc += __shfl_xor(sc, 2);
    if (hq == 0) SS[(size_t)(b * 4 + t) * SLEN + PAST + tk] = tk <= t ? sc : -INFINITY;
}
__device__ __forceinline__ unsigned fkey(float f) { const unsigned u = __builtin_bit_cast(unsigned, f); return (u & 0x80000000u) ? ~u : (u | 0x80000000u); }
__device__ __forceinline__ int wave_isum(int v) {
#pragma unroll
    for (int o = 1; o < 64; o <<= 1) v += __shfl_xor(v, o);
    return v;
}
__device__ __forceinline__ int popc64(u64 m) { return __builtin_popcountll(m); }
__device__ __forceinline__ int lane_rank(u64 m) { return (int)__builtin_amdgcn_mbcnt_hi((unsigned)(m >> 32), __builtin_amdgcn_mbcnt_lo((unsigned)m, 0u)); }

template <int I> struct D2Step {
    static __device__ __forceinline__ void run(const unsigned (&key)[64], unsigned tau, int need, int& taken, unsigned& wlo, unsigned& whi) {
        const bool gt = key[I] > tau, eq = key[I] == tau; const u64 em = __ballot(eq);
        const bool sel = gt || (eq && (taken + lane_rank(em) < need));
        taken += popc64(em);
        const u64 m = __ballot(sel); const unsigned mlo = (unsigned)m, mhi = (unsigned)(m >> 32);
        asm volatile("s_nop 3\n\tv_writelane_b32 %0, %1, %2" : "+v"(wlo) : "s"(mlo), "n"(I));
        asm volatile("s_nop 3\n\tv_writelane_b32 %0, %1, %2" : "+v"(whi) : "s"(mhi), "n"(I));
        D2Step<I + 1>::run(key, tau, need, taken, wlo, whi);
    }
};
template <> struct D2Step<64> { static __device__ __forceinline__ void run(const unsigned (&)[64], unsigned, int, int&, unsigned&, unsigned&) {} };

__device__ __forceinline__ void d2_row(Frame& F, int row) {
    const int lane = F.lane, t = row & (SEQ - 1);
    const float* sc = (const float*)(F.ws + WS_SCORES) + (size_t)row * SEQ;
    u64* mo = (u64*)(F.ws + WS_MASK) + (size_t)row * 64;
    u64 myword = 0;
    if (t < 256) {
        const int lo = lane * 64; myword = (t >= lo + 63) ? ~0ull : (t < lo ? 0ull : ((2ull << (t - lo)) - 1ull));
        mo[lane] = myword; return;
    }
    unsigned key[64];
    const int nfull = (t >> 6) + 1;
#pragma unroll
    for (int i = 0; i < 32; ++i) { const int s = i * 64 + lane; const float v = sc[s]; key[i] = s <= t ? fkey(v) : 0u; }
    if (nfull > 32) {
#pragma unroll
        for (int i = 32; i < 64; ++i) { const int s = i * 64 + lane; const float v = sc[s]; key[i] = s <= t ? fkey(v) : 0u; }
    } else {
#pragma unroll
        for (int i = 32; i < 64; ++i) key[i] = 0u;
    }
    unsigned tau = 0u;
    for (int bit = 31; bit >= 0; --bit) {
        const unsigned cand = tau | (1u << bit); int c = 0;
#pragma unroll
        for (int i = 0; i < 64; ++i) c += (key[i] >= cand) ? 1 : 0;
        if (wave_isum(c) >= 256) tau = cand;
    }
    int cgt = 0;
    { int c = 0;
#pragma unroll
      for (int i = 0; i < 64; ++i) c += (key[i] > tau) ? 1 : 0;
      cgt = wave_isum(c); }
    unsigned wlo = 0u, whi = 0u;
    const int need = 256 - cgt; int taken = 0;
    unsigned tau2 = tau; asm volatile("" : "+v"(tau2));
    D2Step<0>::run(key, tau2, need, taken, wlo, whi);
    mo[lane] = ((u64)whi << 32) | wlo;
}

__device__ __forceinline__ void r2_scan(Frame& F) {
    const int gt = F.vcu * (NWAVES * 64) + F.tid;
    if (gt >= 131072) return;
    const int e = gt * 2, bh = e >> 14, off = e & 16383, h = bh & 7;
    const float cdec = exp2f(128.0f * lg2g(h));
    const float* kv = (const float*)(F.ws + WS_KVC) + (size_t)bh * 32 * 16384 + off;
    bf16_t* sp = (bf16_t*)(F.ws + WS_SPREV) + (size_t)bh * 32 * 16384 + off;
    float s0 = 0.f, s1 = 0.f;
#pragma unroll 4
    for (int n = 0; n < 32; ++n) {
        const f32x2 k = *(const GAS f32x2*)(kv + (size_t)n * 16384);
        *(GAS unsigned*)(sp + (size_t)n * 16384) = pk2(s0, s1);
        s0 = cdec * (s0 + k.x); s1 = cdec * (s1 + k.y);
    }
    float* o = F.out + O_RSP + (size_t)bh * 16384; const int dv = off >> 7, dk = off & 127;
    o[dk * 128 + dv] = s0; o[(dk + 1) * 128 + dv] = s1;
}

__device__ __forceinline__ void s2_row(Frame& F, int q) {
    const int lane = F.lane, wave = F.wave, t = q & 3, n = PAST + t + 1;
    const float* sc = (const float*)(F.ws + WS_SMP + SM_SCORE) + (size_t)q * SLEN;
    int* so = (int*)(F.ws + WS_SMP + SM_SIDX) + q * 256;
    LAS int* cnts = (LAS int*)F.lds;
    unsigned key[33]; const int base = wave * 2112;
#pragma unroll
    for (int i = 0; i < 33; ++i) { const int s = base + i * 64 + lane; key[i] = 0u; if (s < n) key[i] = fkey(sc[s]); }
    __syncthreads();
    unsigned tau = 0u;
    for (int bit = 31; bit >= 0; --bit) {
        const unsigned cand = tau | (1u << bit); int c = 0;
#pragma unroll
        for (int i = 0; i < 33; ++i) c += (key[i] >= cand) ? 1 : 0;
        const int cnt = wave_isum(c);
        LAS int* cb = cnts + (bit & 1) * 8;
        if (lane == 0) cb[wave] = cnt;
        __syncthreads();
        int tot = 0;
#pragma unroll
        for (int w = 0; w < 8; ++w) tot += cb[w];
        if (tot >= 256) tau = cand;
    }
    int cgt = 0, ceq = 0;
#pragma unroll
    for (int i = 0; i < 33; ++i) { cgt += (key[i] > tau) ? 1 : 0; ceq += (key[i] == tau) ? 1 : 0; }
    cgt = wave_isum(cgt); ceq = wave_isum(ceq);
    __syncthreads();
    if (lane == 0) { cnts[16 + wave] = cgt; cnts[32 + wave] = ceq; }
    __syncthreads();
    int gbase = 0, ebase = 0, gtot = 0;
#pragma unroll
    for (int w = 0; w < 8; ++w) { const int g = cnts[16 + w], e = cnts[32 + w]; if (w < wave) { gbase += g; ebase += e; } gtot += g; }
    const int need = 256 - gtot;
    int goff = gbase, eoff = ebase;
    unsigned tau2 = tau; asm volatile("" : "+v"(tau2));
#pragma unroll
    for (int i = 0; i < 33; ++i) {
        const int s = base + i * 64 + lane; const bool gt = key[i] > tau2, eq = key[i] == tau2;
        const u64 gm = __ballot(gt), em = __ballot(eq);
        if (gt) so[goff + lane_rank(gm)] = s;
        if (eq) { const int r = eoff + lane_rank(em); if (r < need) so[gtot + r] = s; }
        goff += popc64(gm); eoff += popc64(em);
        __builtin_amdgcn_sched_barrier(0);
    }
}
namespace fa {
constexpr int KVBLK = 64;
constexpr float SCALE = QK_SCALE;
constexpr size_t SHM_V = KVBLK * 128 * 2, SHM_K = KVBLK * 128 * 2;
constexpr int OFF_V = 0, OFF_K = 2 * SHM_V, OFF_WS = 2 * SHM_V + 2 * SHM_K;
#define KSWZ(row, colB) ((row) * 256 + ((colB) ^ (((row) & 7) << 4)))
#define SBAR() __builtin_amdgcn_sched_barrier(0)
__device__ __forceinline__ unsigned cvtpk(float lo, float hi) { unsigned r; asm volatile("v_cvt_pk_bf16_f32 %0, %1, %2" : "=v"(r) : "v"(lo), "v"(hi)); return r; }
__device__ __forceinline__ int v_st(int k, int c) { const int kk = (k & ~0xC) | ((k & 4) << 1) | ((k & 8) >> 1); return ((kk >> 3) * 4 + (c >> 5)) * 512 + ((kk & 7) * 32 + (c & 31)) * 2; }
__device__ __forceinline__ int v_rd_base(int lane) { return ((lane & 3) << 3) | (((lane >> 2) & 3) << 6) | (((lane >> 4) & 1) << 5) | (((lane >> 5) & 1) << 8); }
constexpr int v_rd_off(int d0, int ks, int half) { return d0 * 512 + ks * 4096 + half * 2048; }
template <int OFF> __device__ __forceinline__ s16x4 tr_read(int vb) { s16x4 r; asm volatile("ds_read_b64_tr_b16 %0, %1 offset:%2" : "=&v"(r) : "v"(vb), "i"(OFF) : "memory"); return r; }
template <int D0> __device__ __forceinline__ void pv_one(f32x16& od, int vb, bf16x8 pa0, bf16x8 pa1, bf16x8 pa2, bf16x8 pa3) {
    const s16x4 l0 = tr_read<v_rd_off(D0, 0, 0)>(vb), h0 = tr_read<v_rd_off(D0, 0, 1)>(vb), l1 = tr_read<v_rd_off(D0, 1, 0)>(vb), h1 = tr_read<v_rd_off(D0, 1, 1)>(vb);
    const s16x4 l2 = tr_read<v_rd_off(D0, 2, 0)>(vb), h2 = tr_read<v_rd_off(D0, 2, 1)>(vb), l3 = tr_read<v_rd_off(D0, 3, 0)>(vb), h3 = tr_read<v_rd_off(D0, 3, 1)>(vb);
    asm volatile("s_waitcnt lgkmcnt(0)" ::: "memory"); SBAR();
#define PK(L, H) (bf16x8){L[0], L[1], L[2], L[3], H[0], H[1], H[2], H[3]}
    od = __builtin_amdgcn_mfma_f32_32x32x16_bf16(pa0, PK(l0, h0), od, 0, 0, 0);
    od = __builtin_amdgcn_mfma_f32_32x32x16_bf16(pa1, PK(l1, h1), od, 0, 0, 0);
    od = __builtin_amdgcn_mfma_f32_32x32x16_bf16(pa2, PK(l2, h2), od, 0, 0, 0);
    od = __builtin_amdgcn_mfma_f32_32x32x16_bf16(pa3, PK(l3, h3), od, 0, 0, 0);
#undef PK
}
__device__ __forceinline__ void pv_d0(f32x16* o, int vb, bf16x8 pa0, bf16x8 pa1, bf16x8 pa2, bf16x8 pa3) {
    pv_one<0>(o[0], vb, pa0, pa1, pa2, pa3); pv_one<1>(o[1], vb, pa0, pa1, pa2, pa3); pv_one<2>(o[2], vb, pa0, pa1, pa2, pa3); pv_one<3>(o[3], vb, pa0, pa1, pa2, pa3);
}
__device__ __forceinline__ void qkt(f32x16& p0, f32x16& p1, const LAS char* Ks, const bf16x8* qr, int r32, int hi) {
    p0 = f32x16{}; p1 = f32x16{};
#pragma unroll
    for (int d0 = 0; d0 < 8; ++d0) { const int cb = (d0 * 16 + hi * 8) * 2;
        const bf16x8 b0 = *(const LAS bf16x8*)(Ks + KSWZ(r32, cb)); const bf16x8 b1 = *(const LAS bf16x8*)(Ks + KSWZ(32 + r32, cb));
        p0 = __builtin_amdgcn_mfma_f32_32x32x16_bf16(b0, qr[d0], p0, 0, 0, 0); p1 = __builtin_amdgcn_mfma_f32_32x32x16_bf16(b1, qr[d0], p1, 0, 0, 0); }
}
__device__ __forceinline__ float softmax_tile(f32x16& p0, f32x16& p1, float& m_reg, float& l_reg, bf16x8& pa0, bf16x8& pa1, bf16x8& pa2, bf16x8& pa3) {
    constexpr float C = SCALE * 1.4426950408889634f;
    float pmax = p0[0];
#pragma unroll
    for (int r = 1; r < 16; ++r) pmax = fmaxf(pmax, p0[r]);
#pragma unroll
    for (int r = 0; r < 16; ++r) pmax = fmaxf(pmax, p1[r]);
    { auto rr = __builtin_amdgcn_permlane32_swap(__float_as_uint(pmax), __float_as_uint(pmax), false, false); pmax = fmaxf(__uint_as_float(rr[0]), __uint_as_float(rr[1])); }
    float alpha = 1.f;
    if (!__all(pmax <= m_reg)) { const float mn = fmaxf(m_reg, pmax); alpha = __builtin_amdgcn_exp2f((m_reg - mn) * C); m_reg = mn; }
    const float mnC = -m_reg * C;
#pragma unroll
    for (int r = 0; r < 16; ++r) { p0[r] = __builtin_amdgcn_exp2f(fmaf(p0[r], C, mnC)); p1[r] = __builtin_amdgcn_exp2f(fmaf(p1[r], C, mnC)); }
    float ps = 0.f;
#pragma unroll
    for (int r = 0; r < 16; ++r) ps += p0[r] + p1[r];
    { auto rr = __builtin_amdgcn_permlane32_swap(__float_as_uint(ps), __float_as_uint(ps), false, false); ps = __uint_as_float(rr[0]) + __uint_as_float(rr[1]); }
    l_reg = l_reg * alpha + ps;
#define PK4(P, BASE, OUT) do { unsigned a0 = cvtpk(P[BASE + 0], P[BASE + 1]), a1 = cvtpk(P[BASE + 2], P[BASE + 3]);   \
    unsigned b0 = cvtpk(P[BASE + 4], P[BASE + 5]), b1 = cvtpk(P[BASE + 6], P[BASE + 7]);                              \
    auto r0 = __builtin_amdgcn_permlane32_swap(a0, b0, false, false); auto r1 = __builtin_amdgcn_permlane32_swap(a1, b1, false, false); \
    u32x4 w = {r0[0], r1[0], r0[1], r1[1]}; OUT = __builtin_bit_cast(bf16x8, w); } while (0)
    PK4(p0, 0, pa0); PK4(p0, 8, pa1); PK4(p1, 0, pa2); PK4(p1, 8, pa3);
#undef PK4
    return alpha;
}

template <bool MASKED>
__device__ __forceinline__ void attn_wg(const bf16_t* qrow, const bf16_t* Kh, const bf16_t* Vh, int ldk, int nt, int ntw, const u64* mrow,
                                        bf16_t* orow0, int ldo, LAS char* lds, int tid) {
    const int wid = tid >> 6, lane = tid & 63, r32 = lane & 31, hi = lane >> 5;
    LAS char* V_lds = lds + OFF_V; LAS char* K_lds = lds + OFF_K;
    LAS float* wsf = (LAS float*)(lds + OFF_WS) + wid * 64;
    float m_reg = -1e30f, l_reg = 0.f; f32x16 o[4] = {}; bf16x8 qr[8];
#pragma unroll
    for (int d0 = 0; d0 < 8; ++d0) qr[d0] = *(const GAS bf16x8*)(qrow + d0 * 16);
    const int sr = tid >> 4, sc = (tid & 15) * 8, vst0 = v_st(sr, sc), vst1 = v_st(32 + sr, sc);
    const int vb0 = (int)(uintptr_t)V_lds + v_rd_base(lane);
    bf16x8 vs0, vs1, ks0, ks1;
#define SLOAD(k0) do { vs0 = *(const GAS bf16x8*)(Vh + (size_t)((k0) + sr) * ldk + sc); vs1 = *(const GAS bf16x8*)(Vh + (size_t)((k0) + 32 + sr) * ldk + sc); \
    ks0 = *(const GAS bf16x8*)(Kh + (size_t)((k0) + sr) * ldk + sc); ks1 = *(const GAS bf16x8*)(Kh + (size_t)((k0) + 32 + sr) * ldk + sc); } while (0)
#define SWRITE(b) do { *(LAS bf16x8*)(V_lds + (b) * SHM_V + vst0) = vs0; *(LAS bf16x8*)(V_lds + (b) * SHM_V + vst1) = vs1; const int kc = sc * 2; \
    *(LAS bf16x8*)(K_lds + (b) * SHM_K + KSWZ(sr, kc)) = ks0; *(LAS bf16x8*)(K_lds + (b) * SHM_K + KSWZ(32 + sr, kc)) = ks1; } while (0)
    __syncthreads();
    SLOAD(0); SWRITE(0); if (nt > 1) SLOAD(KVBLK);
    __syncthreads();
    for (int j = 0; j < nt; ++j) {
        const int cur = j & 1;
        if (j + 1 < nt) { SWRITE(cur ^ 1); }
        if (j + 2 < nt) SLOAD((j + 2) * KVBLK);
        if (j < ntw) {
            u64 mw = 0; if (MASKED) mw = mrow[j];
            f32x16 p0, p1; bf16x8 pa0, pa1, pa2, pa3;
            qkt(p0, p1, K_lds + cur * SHM_K, qr, r32, hi);
            if (MASKED) { const unsigned lo = (unsigned)mw >> (4 * hi), hh = (unsigned)(mw >> 32) >> (4 * hi);
#pragma unroll
                for (int r = 0; r < 16; ++r) { const int bit = (r & 3) + 8 * (r >> 2); p0[r] = ((lo >> bit) & 1u) ? p0[r] : -INFINITY; p1[r] = ((hh >> bit) & 1u) ? p1[r] : -INFINITY; } }
            const float alpha = softmax_tile(p0, p1, m_reg, l_reg, pa0, pa1, pa2, pa3);
            if (__any(alpha < 1.f)) { if (hi == 0) wsf[r32] = alpha; asm volatile("s_waitcnt lgkmcnt(0)" ::: "memory");
#pragma unroll
                for (int d = 0; d < 4; ++d)
#pragma unroll
                    for (int r = 0; r < 16; ++r) o[d][r] *= wsf[crow(r, hi)]; }
            pv_d0(o, vb0 + cur * (int)SHM_V, pa0, pa1, pa2, pa3);
        }
        __syncthreads();
    }
    if (hi == 0) wsf[32 + r32] = l_reg; asm volatile("s_waitcnt lgkmcnt(0)" ::: "memory");
    if (ntw > 0) {
#pragma unroll
        for (int r = 0; r < 16; ++r) { const int orow = crow(r, hi); const float rl = __builtin_amdgcn_rcpf(wsf[32 + orow]);
#pragma unroll
            for (int d0 = 0; d0 < 4; ++d0) *(GAS bf16_t*)(orow0 + (size_t)orow * ldo + d0 * 32 + r32) = (bf16_t)f2bf(o[d0][r] * rl); }
    }
#undef SLOAD
#undef SWRITE
}
}
__device__ __forceinline__ void d3_unit(Frame& F, int b, int g, int i) {
    const int lane = F.lane, wave = F.wave, r32 = lane & 31, hi = lane >> 5;
    const int qblk = wave < 4 ? i : 127 - i, head = 4 * g + (wave & 3);
    const int ntw = (qblk >> 1) + 1, nt = ((127 - i) >> 1) + 1;
    const size_t row0 = (size_t)b * SEQ + qblk * 32;
    const bf16_t* qrow = (const bf16_t*)(F.ws + WS_DQ) + (row0 + r32) * 1024 + head * 128 + hi * 8;
    const bf16_t* Kh = (const bf16_t*)(F.ws + WS_DK) + (size_t)b * SEQ * 256 + g * 128; const bf16_t* Vh = (const bf16_t*)(F.ws + WS_DV) + (size_t)b * SEQ * 256 + g * 128;
    const u64* mrow = (const u64*)(F.ws + WS_MASK) + (row0 + r32) * 64;
    bf16_t* orow0 = (bf16_t*)(F.ws + WS_DSAO) + row0 * 1024 + head * 128;
    fa::attn_wg<true>(qrow, Kh, Vh, 256, nt, ntw, mrow, orow0, 1024, (LAS char*)F.lds, F.tid);
}
__device__ __forceinline__ void xattn_unit(Frame& F, int b, int h, int qb) {
    const int lane = F.lane, wave = F.wave, r32 = lane & 31, hi = lane >> 5;
    const size_t row0 = (size_t)b * SEQ + qb * 256 + wave * 32;
    const bf16_t* qrow = (const bf16_t*)(F.ws + WS_QM) + (row0 + r32) * 512 + h * 128 + hi * 8;
    const bf16_t* Kh = (const bf16_t*)(F.ws + WS_MEMKB) + (size_t)b * 256 * 512 + h * 128; const bf16_t* Vh = (const bf16_t*)(F.ws + WS_MEMVB) + (size_t)b * 256 * 512 + h * 128;
    bf16_t* orow0 = (bf16_t*)(F.ws + WS_OM) + row0 * 512 + h * 128;
    fa::attn_wg<false>(qrow, Kh, Vh, 512, 4, 4, nullptr, orow0, 512, (LAS char*)F.lds, F.tid);
}

__device__ __forceinline__ void r3_unit(Frame& F, const Args& A, int b, int n, int hp) {
    const int lane = F.lane, wave = F.wave, r32 = lane & 31, hi = lane >> 5, tb = wave & 3, hl = wave >> 2, head = 2 * hp + hl;
    LAS bf16_t* Vt = (LAS bf16_t*)F.lds + hl * (128 * TLD);
    const size_t row0 = (size_t)b * SEQ + n * 128;
    const bf16_t* RQ = (const bf16_t*)(F.ws + WS_RQ); const bf16_t* RK = (const bf16_t*)(F.ws + WS_RK); const bf16_t* RV = (const bf16_t*)(F.ws + WS_RV);
    __syncthreads();
    stage_tile128(RV + row0 * 1024 + (2 * hp) * 128, 1024, (LAS bf16_t*)F.lds, F.tid);
    stage_tile128(RV + row0 * 1024 + (2 * hp + 1) * 128, 1024, (LAS bf16_t*)F.lds + 128 * TLD, F.tid);
    bf16x8 qf[8];
#pragma unroll
    for (int ks = 0; ks < 8; ++ks) qf[ks] = *(const GAS bf16x8*)(RQ + (row0 + 32 * tb + r32) * 1024 + head * 128 + 16 * ks + 8 * hi);
    __syncthreads();
    f32x16 o[4] = {};
    for (int jb = 0; jb <= tb; ++jb) {
        f32x16 st = {};
#pragma unroll
        for (int ks = 0; ks < 8; ++ks) { const bf16x8 kf = *(const GAS bf16x8*)(RK + (row0 + 32 * jb + r32) * 1024 + head * 128 + 16 * ks + 8 * hi);
            st = __builtin_amdgcn_mfma_f32_32x32x16_bf16(kf, qf[ks], st, 0, 0, 0); }
        if (jb == tb) {
#pragma unroll
            for (int r = 0; r < 16; ++r) if (crow(r, hi) > r32) st[r] = 0.f;
        }
        bf16x8 pa0, pa1;
#define PK4(P, BASE, OUT) do { unsigned a0 = fa::cvtpk(P[BASE + 0], P[BASE + 1]), a1 = fa::cvtpk(P[BASE + 2], P[BASE + 3]);   \
    unsigned b0 = fa::cvtpk(P[BASE + 4], P[BASE + 5]), b1 = fa::cvtpk(P[BASE + 6], P[BASE + 7]);                              \
    auto r0 = __builtin_amdgcn_permlane32_swap(a0, b0, false, false); auto r1 = __builtin_amdgcn_permlane32_swap(a1, b1, false, false); \
    u32x4 w = {r0[0], r1[0], r0[1], r1[1]}; OUT = __builtin_bit_cast(bf16x8, w); } while (0)
        PK4(st, 0, pa0); PK4(st, 8, pa1);
#undef PK4
#pragma unroll
        for (int d = 0; d < 4; ++d) { const bf16x8 v0 = tr_frag(Vt, TLD, 32 * jb, 32 * d, lane), v1 = tr_frag(Vt, TLD, 32 * jb + 16, 32 * d, lane);
            o[d] = __builtin_amdgcn_mfma_f32_32x32x16_bf16(pa0, v0, o[d], 0, 0, 0); o[d] = __builtin_amdgcn_mfma_f32_32x32x16_bf16(pa1, v1, o[d], 0, 0, 0); }
    }
    {
        const bf16_t* SP = (const bf16_t*)(F.ws + WS_SPREV) + ((size_t)(b * 8 + head) * 32 + n) * 16384;
#pragma unroll
        for (int d = 0; d < 4; ++d)
#pragma unroll
            for (int ks = 0; ks < 8; ++ks) { const bf16x8 sf = *(const GAS bf16x8*)(SP + (32 * d + r32) * 128 + 16 * ks + 8 * hi);
                o[d] = __builtin_amdgcn_mfma_f32_32x32x16_bf16(qf[ks], sf, o[d], 0, 0, 0); }
    }
    const float* gn = (const float*)A.in[I_GNRET] + head * 128; const bf16_t* RG = (const bf16_t*)(F.ws + WS_RG); bf16_t* RY = (bf16_t*)(F.ws + WS_RETY);
    float gnv[4];
#pragma unroll
    for (int d = 0; d < 4; ++d) gnv[d] = gn[32 * d + r32];
#pragma unroll
    for (int r = 0; r < 16; ++r) {
        float s1 = (o[0][r] + o[1][r]) + (o[2][r] + o[3][r]);
#pragma unroll
        for (int x = 1; x < 32; x <<= 1) s1 += __shfl_xor(s1, x);
        const float mu = s1 * (1.0f / 128.0f);
        float s2 = 0.f;
#pragma unroll
        for (int d = 0; d < 4; ++d) { const float c = o[d][r] - mu; s2 += c * c; }
#pragma unroll
        for (int x = 1; x < 32; x <<= 1) s2 += __shfl_xor(s2, x);
        const float rs = 1.0f / sqrtf(s2 * (1.0f / 128.0f) + EPS);
        const size_t ro = (row0 + 32 * tb + crow(r, hi)) * 1024 + head * 128 + r32;
#pragma unroll
        for (int d = 0; d < 4; ++d) { const float sg = bf2f(*(const GAS bf16_t*)(RG + ro + 32 * d)); *(GAS bf16_t*)(RY + ro + 32 * d) = (bf16_t)f2bf((o[d][r] - mu) * rs * gnv[d] * sg); }
    }
}

__device__ __forceinline__ void s3_ret_unit(Frame& F, const Args& A, int bh) {
    const int tid = F.tid, b = bh >> 3, h = bh & 7, dv = tid & 127, sl = tid >> 7;
    LAS float* qs = (LAS float*)F.lds;
    LAS float* ks = qs + 512;
    LAS float* vs = ks + 512;
    LAS float* oc = vs + 512;
    LAS float* st = oc + 2048;
    LAS float* red = st + 16;
    const bf16_t* RQ = (const bf16_t*)(F.ws + WS_SMP + SM_RQ); const bf16_t* RK = (const bf16_t*)(F.ws + WS_SMP + SM_RK); const bf16_t* RV = (const bf16_t*)(F.ws + WS_SMP + SM_RV);
    __syncthreads();
    { const int t = tid >> 7, d = tid & 127; const size_t o = (size_t)(b * 4 + t) * 1024 + h * 128 + d; qs[tid] = bf2f(RQ[o]); ks[tid] = bf2f(RK[o]); vs[tid] = bf2f(RV[o]); }
    __syncthreads();
    if (tid < 16) { const int t = tid >> 2, j = tid & 3; float s = 0.f; for (int d = 0; d < 128; ++d) s += qs[t * 128 + d] * ks[j * 128 + d]; st[tid] = j <= t ? s : 0.f; }
    const float* S0 = (const float*)A.in[I_STATE] + (size_t)bh * 16384; float* SO = F.out + O_RSS + (size_t)bh * 16384;
    const float g4 = exp2f(4.0f * lg2g(h));
    const float v0 = vs[dv], v1 = vs[128 + dv], v2 = vs[256 + dv], v3 = vs[384 + dv];
    float c0 = 0.f, c1 = 0.f, c2 = 0.f, c3 = 0.f;
#pragma unroll 4
    for (int i = 0; i < 32; ++i) { const int dk = sl * 32 + i; const float s0 = S0[dk * 128 + dv];
        c0 += qs[dk] * s0; c1 += qs[128 + dk] * s0; c2 += qs[256 + dk] * s0; c3 += qs[384 + dk] * s0;
        SO[dk * 128 + dv] = g4 * (s0 + ks[dk] * v0 + ks[128 + dk] * v1 + ks[256 + dk] * v2 + ks[384 + dk] * v3); }
    oc[(sl * 4 + 0) * 128 + dv] = c0; oc[(sl * 4 + 1) * 128 + dv] = c1; oc[(sl * 4 + 2) * 128 + dv] = c2; oc[(sl * 4 + 3) * 128 + dv] = c3;
    __syncthreads();
    const int t = sl; float o = oc[(0 * 4 + t) * 128 + dv] + oc[(1 * 4 + t) * 128 + dv] + oc[(2 * 4 + t) * 128 + dv] + oc[(3 * 4 + t) * 128 + dv];
    o += st[t * 4 + 0] * v0 + st[t * 4 + 1] * v1 + st[t * 4 + 2] * v2 + st[t * 4 + 3] * v3;
    const float ws1 = wave_sum(o); if (F.lane == 0) red[t * 4 + (F.wave & 1)] = ws1;
    __syncthreads();
    const float mu = (red[t * 4 + 0] + red[t * 4 + 1]) * (1.0f / 128.0f); const float c = o - mu;
    const float ws2 = wave_sum(c * c); if (F.lane == 0) red[t * 4 + 2 + (F.wave & 1)] = ws2;
    __syncthreads();
    const float rs = 1.0f / sqrtf((red[t * 4 + 2] + red[t * 4 + 3]) * (1.0f / 128.0f) + EPS);
    const size_t ro = (size_t)(b * 4 + t) * 1024 + h * 128 + dv;
    const float sg = bf2f(((const bf16_t*)(F.ws + WS_SMP + SM_RG))[ro]);
    ((bf16_t*)(F.ws + WS_SMP + SM_RETY))[ro] = (bf16_t)f2bf(c * rs * ((const float*)A.in[I_GNRET])[h * 128 + dv] * sg);
}

template <typename T> __device__ __forceinline__ float ldv(const T* p);
template <> __device__ __forceinline__ float ldv<float>(const float* p) { return *(const GAS float*)p; }
template <> __device__ __forceinline__ float ldv<bf16_t>(const bf16_t* p) { return bf2f(*(const GAS bf16_t*)p); }
template <typename T, class KP, class VP>
__device__ __forceinline__ f32x2 wave_attn256(const LAS float* qv, LAS float* lg, KP kp, VP vp, int lane) {
    const int sub = lane & 15, kq = lane >> 4; float q8[8];
#pragma unroll
    for (int e = 0; e < 8; ++e) q8[e] = qv[8 * sub + e];
    for (int it = 0; it < 64; ++it) { const int key = 4 * it + kq; const T* k = kp(key) + 8 * sub; float d = 0.f;
#pragma unroll
        for (int e = 0; e < 8; ++e) d += q8[e] * ldv<T>(k + e);
        d = sum16(d); if (sub == 0) lg[key] = d; }
    LDS_WAIT();
    float l0 = lg[lane], l1 = lg[64 + lane], l2 = lg[128 + lane], l3 = lg[192 + lane];
    const float mx = wave_max(fmaxf(fmaxf(l0, l1), fmaxf(l2, l3)));
    l0 = __expf(l0 - mx); l1 = __expf(l1 - mx); l2 = __expf(l2 - mx); l3 = __expf(l3 - mx);
    const float inv = 1.0f / wave_sum((l0 + l1) + (l2 + l3));
    lg[lane] = l0 * inv; lg[64 + lane] = l1 * inv; lg[128 + lane] = l2 * inv; lg[192 + lane] = l3 * inv;
    LDS_WAIT();
    float a0 = 0.f, a1 = 0.f;
#pragma unroll 4
    for (int key = 0; key < 256; ++key) { const float p = lg[key]; const T* v = vp(key) + 2 * lane; a0 += p * ldv<T>(v); a1 += p * ldv<T>(v + 1); }
    return (f32x2){a0, a1};
}
__device__ __forceinline__ void s3_attn_unit(Frame& F, const Args& A, int q) {
    const int lane = F.lane, wave = F.wave, tid = F.tid, b = q >> 2, g = wave >> 2;
    LAS int* koff = (LAS int*)F.lds;
    LAS float* qv = (LAS float*)(F.lds + 1024) + wave * 128; LAS float* lg = (LAS float*)(F.lds + 1024 + 4096) + wave * 256;
    const int* sidx = (const int*)(F.ws + WS_SMP + SM_SIDX) + q * 256; const int* PT = (const int*)A.in[I_PT];
    __syncthreads();
    if (tid < 256) { const int s = sidx[tid]; int v; if (s < PAST) v = (PT[b * 128 + (s >> 7)] * 128 + (s & 127)); else v = -(1 + (b * 4 + (s - PAST))); koff[tid] = v; }
    { const bf16_t* dq = (const bf16_t*)(F.ws + WS_SMP + SM_DQ) + (size_t)q * 1024 + wave * 128; qv[lane] = bf2f(dq[lane]) * QK_SCALE; qv[64 + lane] = bf2f(dq[64 + lane]) * QK_SCALE; }
    __syncthreads();
    const float* CK = (const float*)A.in[I_CK]; const float* CV = (const float*)A.in[I_CV]; const float* NK = F.out + O_KS; const float* NV = F.out + O_VS;
    auto kp = [&](int key) -> const float* { const int v = koff[key]; return v >= 0 ? CK + (size_t)v * 256 + g * 128 : NK + (size_t)(-1 - v) * 256 + g * 128; };
    auto vp = [&](int key) -> const float* { const int v = koff[key]; return v >= 0 ? CV + (size_t)v * 256 + g * 128 : NV + (size_t)(-1 - v) * 256 + g * 128; };
    const f32x2 o = wave_attn256<float>(qv, lg, kp, vp, lane);
    *(GAS unsigned*)((bf16_t*)(F.ws + WS_SMP + SM_DSAO) + (size_t)q * 1024 + wave * 128 + 2 * lane) = pk2(o.x, o.y);
}
__device__ __forceinline__ void s7_xattn_unit(Frame& F, int b) {
    const int lane = F.lane, wave = F.wave;
    LAS float* qv = (LAS float*)(F.lds) + wave * 128; LAS float* lg = (LAS float*)(F.lds + 4096) + wave * 256;
    const bf16_t* MK = (const bf16_t*)(F.ws + WS_MEMKB) + (size_t)(2 + b) * 256 * 512; const bf16_t* MV = (const bf16_t*)(F.ws + WS_MEMVB) + (size_t)(2 + b) * 256 * 512;
    __syncthreads();
    for (int c = 0; c < 2; ++c) { const int th = wave * 2 + c, t = th >> 2, h = th & 3, q = b * 4 + t;
        const bf16_t* qm = (const bf16_t*)(F.ws + WS_SMP + SM_QM) + (size_t)q * 512 + h * 128;
        LDS_WAIT(); qv[lane] = bf2f(qm[lane]) * QK_SCALE; qv[64 + lane] = bf2f(qm[64 + lane]) * QK_SCALE; LDS_WAIT();
        auto kp = [&](int key) -> const bf16_t* { return MK + (size_t)key * 512 + h * 128; };
        auto vp = [&](int key) -> const bf16_t* { return MV + (size_t)key * 512 + h * 128; };
        const f32x2 o = wave_attn256<bf16_t>(qv, lg, kp, vp, lane);
        *(GAS unsigned*)((bf16_t*)(F.ws + WS_SMP + SM_OM) + (size_t)q * 512 + h * 128 + 2 * lane) = pk2(o.x, o.y); }
}
__device__ __forceinline__ f32x4 ld_bf4(const bf16_t* p) { const u32x2 w = *(const GAS u32x2*)p; return (f32x4){bflo(w.x), bfhi(w.x), bflo(w.y), bfhi(w.y)}; }
__device__ __forceinline__ float rowsq64(const f32x4& a, const f32x4& b, const f32x4& c, const f32x4& d) {
    float s = (a.x * a.x + a.y * a.y) + (a.z * a.z + a.w * a.w) + (b.x * b.x + b.y * b.y) + (b.z * b.z + b.w * b.w)
            + (c.x * c.x + c.y * c.y) + (c.z * c.z + c.w * c.w) + (d.x * d.x + d.y * d.y) + (d.z * d.z + d.w * d.w);
    s += __shfl_xor(s, 16); s += __shfl_xor(s, 32); return s;
}
__device__ __forceinline__ float rstd32(const float* ssq, int row) {
    const GAS f32x4* p = (const GAS f32x4*)(ssq + (size_t)row * 32); float s = 0.f;
#pragma unroll
    for (int i = 0; i < 8; ++i) { const f32x4 v = p[i]; s += (v.x + v.y) + (v.z + v.w); }
    return 1.0f / sqrtf(s * (1.0f / DM) + EPS);
}
struct EpiMerge {
    static constexpr bool PERM = false, AFTER_DRAIN = false;
    const bf16_t* GA; const bf16_t* GB; float* T1; bf16_t* MG;
    __device__ __forceinline__ void operator()(const f32x4 (&acc)[2][2][4][2], const pg8::Unit& u, int wr, int wc, int fr, int fq) const {
        const bool second = u.pm >= 32; const int pm = second ? u.pm - 32 : u.pm, pn = second ? u.pn - 8 : u.pn;
        const int rowb = pm * 256 + wr * 64 + fr, cb = pn * 256 + 32 * wc + 4 * fq;
#pragma unroll
        for (int ai = 0; ai < 2; ++ai)
#pragma unroll
            for (int m = 0; m < 4; ++m) { const size_t ro = (size_t)(rowb + ai * 128 + m * 16) * DM + cb;
#pragma unroll
                for (int bj = 0; bj < 2; ++bj)
#pragma unroll
                    for (int n = 0; n < 2; ++n) { const size_t off = ro + bj * 128 + 16 * n;
                        if (!second) *(GAS f32x4*)(T1 + off) = ld_bf4(GA + off) * acc[ai][bj][m][n];
                        else st_bf4(MG + off, *(const GAS f32x4*)(T1 + off) + ld_bf4(GB + off) * acc[ai][bj][m][n]); } }
    }
};
struct EpiResid {
    static constexpr bool PERM = false, AFTER_DRAIN = false;
    const float* R; float* H; bf16_t* HB; float* SSQ;
    __device__ __forceinline__ void operator()(const f32x4 (&acc)[2][2][4][2], const pg8::Unit& u, int wr, int wc, int fr, int fq) const {
        const int rowb = u.pm * 256 + wr * 64 + fr, cb = u.pn * 256 + 32 * wc + 4 * fq;
#pragma unroll
        for (int ai = 0; ai < 2; ++ai)
#pragma unroll
            for (int m = 0; m < 4; ++m) { const int row = rowb + ai * 128 + m * 16; const size_t ro = (size_t)row * DM + cb; f32x4 v[2][2];
#pragma unroll
                for (int bj = 0; bj < 2; ++bj)
#pragma unroll
                    for (int n = 0; n < 2; ++n) { const size_t off = ro + bj * 128 + 16 * n; v[bj][n] = *(const GAS f32x4*)(R + off) + acc[ai][bj][m][n];
                        *(GAS f32x4*)(H + off) = v[bj][n]; if (HB) st_bf4(HB + off, v[bj][n]); }
                const float s = rowsq64(v[0][0], v[0][1], v[1][0], v[1][1]);
                if (fq == 0) SSQ[(size_t)row * 32 + u.pn * 4 + wc] = s; }
    }
};
struct EpiQm {
    static constexpr bool PERM = false, AFTER_DRAIN = false;
    const float* SSQ; bf16_t* QM;
    __device__ __forceinline__ void operator()(const f32x4 (&acc)[2][2][4][2], const pg8::Unit& u, int wr, int wc, int fr, int fq) const {
        const int rowb = u.pm * 256 + wr * 64 + fr, cb = u.pn * 256 + 32 * wc + 4 * fq;
#pragma unroll
        for (int ai = 0; ai < 2; ++ai)
#pragma unroll
            for (int m = 0; m < 4; ++m) { const int row = rowb + ai * 128 + m * 16; const float rs = rstd32(SSQ, row);
#pragma unroll
                for (int bj = 0; bj < 2; ++bj)
#pragma unroll
                    for (int n = 0; n < 2; ++n) st_bf4(QM + (size_t)row * MEMW + cb + bj * 128 + 16 * n, acc[ai][bj][m][n] * rs); }
    }
};
struct EpiUp {
    static constexpr bool PERM = false, AFTER_DRAIN = false;
    const float* SSQ; bf16_t* ACT;
    __device__ __forceinline__ void operator()(const f32x4 (&acc)[2][2][4][2], const pg8::Unit& u, int wr, int wc, int fr, int fq) const {
        const int rowb = u.pm * 256 + wr * 64 + fr, cb = u.pn * 256 + 32 * wc + 4 * fq;
#pragma unroll
        for (int ai = 0; ai < 2; ++ai)
#pragma unroll
            for (int m = 0; m < 4; ++m) { const int row = rowb + ai * 128 + m * 16; const float rs = rstd32(SSQ, row);
#pragma unroll
                for (int bj = 0; bj < 2; ++bj)
#pragma unroll
                    for (int n = 0; n < 2; ++n) { f32x4 v = acc[ai][bj][m][n] * rs; v.x = fmaxf(v.x, 0.f); v.y = fmaxf(v.y, 0.f); v.z = fmaxf(v.z, 0.f); v.w = fmaxf(v.w, 0.f);
                        st_bf4(ACT + (size_t)row * DFF + cb + bj * 128 + 16 * n, v * v); } }
    }
};
__device__ __forceinline__ void final_norm_row(float* y, const float* ssq, int np, const float* g, int lane) {
    float s = 0.f; for (int i = lane; i < np; i += 64) s += ssq[i]; s = wave_sum(s);
    const float rs = 1.0f / sqrtf(s * (1.0f / DM) + EPS);
    GAS f32x4* yr = (GAS f32x4*)y + lane; const GAS f32x4* gr = (const GAS f32x4*)g + lane;
#pragma unroll
    for (int j = 0; j < 8; ++j) { const f32x4 v = yr[64 * j], gg = gr[64 * j]; yr[64 * j] = v * rs * gg; }
}
__device__ __forceinline__ float rstd_n(const float* ssq, int n) { float s = 0.f; for (int i = 0; i < n; ++i) s += ssq[i]; return 1.0f / sqrtf(s * (1.0f / DM) + EPS); }
constexpr int N_PHASES = 13;
__global__ void __launch_bounds__(NWAVES * 64, 2) mega_fwd(Args args) {
    extern __shared__ __attribute__((aligned(16))) unsigned char lds_raw[];
    Frame F;
    F.lds = (LAS unsigned char*)lds_raw; F.ws = args.ws; F.out = args.out;
    F.tid = threadIdx.x; F.lane = F.tid & 63; F.wave = __builtin_amdgcn_readfirstlane(F.tid >> 6);
    F.G = gridDim.x; { const int bx = blockIdx.x; F.vcu = (F.G % 8 == 0) ? (bx % 8) * (F.G / 8) + bx / 8 : bx; }
    volatile LAS unsigned* MISC = (volatile LAS unsigned*)(F.lds + MISC_OFF);
    for (int u = F.tid; u < (LDS_BYTES - LDSCTL_OFF) / 4; u += NWAVES * 64) ((LAS unsigned*)(F.lds + LDSCTL_OFF))[u] = 0u;
    __syncthreads();
    unsigned char* ws = args.ws;
    const bool multi = (args.ph_hi - args.ph_lo) > 1;
    XcdBarrier bar; bar.bar = (unsigned*)(ws + WS_CTL) + CW_BAR; bar.x = 0; bar.st = nullptr;
    if (multi) bar = xcd_barrier_post((unsigned*)(ws + WS_CTL) + CW_BAR, MISC + 8);
    const int lo = args.ph_lo, hi = args.ph_hi, G = F.G, cid = (int)blockIdx.x;
    LAS unsigned char* lds = F.lds; LAS float* red = (LAS float*)lds;
#ifndef PH_MASK
#define PH_MASK 0xFFFF
#endif
#define PHASE_ON(k) ((PH_MASK >> (k)) & 1)
#define IN(k) (lo <= (k) && (k) < hi)
#define SEAM(k) do { if (IN(k) && IN((k) + 1)) xcd_barrier(bar); } while (0)
    float* out = args.out;
    unsigned char* sm = ws + WS_SMP;

    if (PHASE_ON(0) && IN(0)) { p0_prologue(F, args); }
    SEAM(0);
    if (PHASE_ON(1) && IN(1)) {
        {
            pg8::Gemm g{(const bf16_t*)(ws + WS_XN), (const bf16_t*)(ws + WS_WT1), MP, NV1, DM};
            OrderX S; S.initx(MP, NV1, G, cid, 8, 32, 43, 4);
            EpiIn E{ws, out};
            pg8::gemm_phase<EpiIn, OrderX, true, true>(lds, g, S, E);
        }
        for (int nb = cid; nb < NV1 / 32; nb += G) {
            const f32x16 acc = skinny_partial((const bf16_t*)(sm + SM_XN), DM, (const bf16_t*)(ws + WS_WT1), DM, nb, F.wave, F.lane);
            float v1, v2; skinny_reduce(acc, red, F.wave, F.lane, F.tid, v1, v2);
            epi_in_sample(ws, out, F.tid >> 4, nb, F.tid & 15, v1, v2);
        }
    }
    SEAM(1);
    if (PHASE_ON(2) && IN(2)) {
        for (int u = F.vcu; u < 1056 + 512 + 256 + 8; u += G) {
            if (u < 1056) { const int b = u / 528, x = u % 528; int qb = (int)((sqrtf(8.0f * x + 1.0f) - 1.0f) * 0.5f); while ((qb + 1) * (qb + 2) / 2 <= x) ++qb; while (qb * (qb + 1) / 2 > x) --qb;
                d1_unit(F, b, qb, x - qb * (qb + 1) / 2); }
            else if (u < 1568) { const int x = u - 1056; r1_unit(F, x >> 5, x & 31); }
            else if (u < 1824) { const int x = u - 1568; s1_unit(F, args, x >> 5, x & 31); }
            else { if (F.wave == 0) s1_tail(F, u - 1824); }
        }
    }
    SEAM(2);
    if (PHASE_ON(3) && IN(3)) {
        if (F.vcu < MS) s2_row(F, F.vcu);
        r2_scan(F);
        for (int row = F.vcu * NWAVES + F.wave; row < MP; row += G * NWAVES) d2_row(F, row);
    }
    SEAM(3);
    if (PHASE_ON(4) && IN(4)) {
        for (int u = F.vcu; u < 256; u += G) d3_unit(F, u >> 7, (u >> 6) & 1, u & 63);
        for (int u = F.vcu; u < 256; u += G) r3_unit(F, args, u >> 7, (u >> 2) & 31, u & 3);
        for (int u = F.vcu; u < 96; u += G) { if (u < 32) s3_attn_unit(F, args, u); else s3_ret_unit(F, args, u - 32); }
    }
    SEAM(4);
    if (PHASE_ON(5) && IN(5)) {
        {
            pg8::Gemm g{(const bf16_t*)(ws + WS_RETY), (const bf16_t*)(ws + WS_WRO), MP, DM, 1024};
            OrderDual S; S.init(MP, DM, G, cid);
            EpiMerge E{(const bf16_t*)(ws + WS_GA), (const bf16_t*)(ws + WS_GB), (float*)(ws + WS_T1), (bf16_t*)(ws + WS_MERGED)};
            pg8::gemm_phase<EpiMerge, OrderDual, false, true>(lds, g, S, E);
        }
        for (int nb = cid; nb < DM / 32; nb += G) {
            const f32x16 a1 = skinny_partial((const bf16_t*)(sm + SM_RETY), 1024, (const bf16_t*)(ws + WS_WRO), 1024, nb, F.wave, F.lane);
            const f32x16 a2 = skinny_partial((const bf16_t*)(sm + SM_DSAO), 1024, (const bf16_t*)(ws + WS_WDO), 1024, nb, F.wave, F.lane);
            float y1, y2, z1, z2; skinny_reduce(a1, red, F.wave, F.lane, F.tid, y1, y2); skinny_reduce(a2, red, F.wave, F.lane, F.tid, z1, z2);
            const int row = F.tid >> 4, col = nb * 32 + (F.tid & 15); const size_t o = (size_t)row * DM + col;
            const bf16_t* ga = (const bf16_t*)(sm + SM_GA); const bf16_t* gb = (const bf16_t*)(sm + SM_GB); bf16_t* mg = (bf16_t*)(sm + SM_MERGED);
            st1(mg + o, bf2f(ga[o]) * y1 + bf2f(gb[o]) * z1); st1(mg + o + 16, bf2f(ga[o + 16]) * y2 + bf2f(gb[o + 16]) * z2);
        }
    }
    SEAM(5);
    if (PHASE_ON(6) && IN(6)) {
        {
            pg8::Gemm g{(const bf16_t*)(ws + WS_MERGED), (const bf16_t*)(ws + WS_WO), MP, DM, DM};
            pg8::StaticOrder S; S.init(MP, DM, G, cid);
            EpiResid E{(const float*)args.in[I_XP], (float*)(ws + WS_H1), (bf16_t*)(ws + WS_H1B), (float*)(ws + WS_SSQ)};
            pg8::gemm_phase<EpiResid, pg8::StaticOrder, false, true>(lds, g, S, E);
        }
        for (int nb = cid; nb < DM / 32; nb += G) {
            const f32x16 a1 = skinny_partial((const bf16_t*)(sm + SM_MERGED), DM, (const bf16_t*)(ws + WS_WO), DM, nb, F.wave, F.lane);
            float y1, y2; skinny_reduce(a1, red, F.wave, F.lane, F.tid, y1, y2);
            const int row = F.tid >> 4, col = nb * 32 + (F.tid & 15); const size_t o = (size_t)row * DM + col; const float* xs = (const float*)args.in[I_XS];
            y1 += xs[o]; y2 += xs[o + 16]; ((float*)(sm + SM_H1))[o] = y1; ((float*)(sm + SM_H1))[o + 16] = y2; st1((bf16_t*)(sm + SM_H1B) + o, y1); st1((bf16_t*)(sm + SM_H1B) + o + 16, y2);
            const float s = sum16(y1 * y1 + y2 * y2); if ((F.tid & 15) == 0) ((float*)(sm + SM_SSQ))[row * 64 + nb] = s;
        }
    }
    SEAM(6);
    if (PHASE_ON(7) && IN(7)) {
        {
            pg8::Gemm g{(const bf16_t*)(ws + WS_H1B), (const bf16_t*)(ws + WS_WMQ), MP, MEMW, DM};
            pg8::StaticOrder S; S.init(MP, MEMW, G, cid);
            EpiQm E{(const float*)(ws + WS_SSQ), (bf16_t*)(ws + WS_QM)};
            pg8::gemm_phase<EpiQm, pg8::StaticOrder, false, true>(lds, g, S, E);
        }
        for (int nb = cid; nb < MEMW / 32; nb += G) {
            const f32x16 a1 = skinny_partial((const bf16_t*)(sm + SM_H1B), DM, (const bf16_t*)(ws + WS_WMQ), DM, nb, F.wave, F.lane);
            float y1, y2; skinny_reduce(a1, red, F.wave, F.lane, F.tid, y1, y2);
            const int row = F.tid >> 4, col = nb * 32 + (F.tid & 15); const float rs = rstd_n((const float*)(sm + SM_SSQ) + row * 64, 64);
            st1((bf16_t*)(sm + SM_QM) + row * MEMW + col, y1 * rs); st1((bf16_t*)(sm + SM_QM) + row * MEMW + col + 16, y2 * rs);
        }
    }
    SEAM(7);
    if (PHASE_ON(8) && IN(8)) {
        for (int u = F.vcu; u < 136; u += G) { if (u < 128) xattn_unit(F, u >> 6, (u >> 4) & 3, u & 15); else s7_xattn_unit(F, u - 128); }
    }
    SEAM(8);
    if (PHASE_ON(9) && IN(9)) {
        {
            pg8::Gemm g{(const bf16_t*)(ws + WS_OM), (const bf16_t*)(ws + WS_WMO), MP, DM, MEMW};
            pg8::StaticOrder S; S.init(MP, DM, G, cid);
            EpiResid E{(const float*)(ws + WS_H1), (float*)(ws + WS_H1), (bf16_t*)(ws + WS_H1B), (float*)(ws + WS_SSQ + 1 * MiB)};
            pg8::gemm_phase<EpiResid, pg8::StaticOrder, false, true>(lds, g, S, E);
        }
        for (int nb = cid; nb < DM / 32; nb += G) {
            const f32x16 a1 = skinny_partial((const bf16_t*)(sm + SM_OM), MEMW, (const bf16_t*)(ws + WS_WMO), MEMW, nb, F.wave, F.lane);
            float y1, y2; skinny_reduce(a1, red, F.wave, F.lane, F.tid, y1, y2);
            const int row = F.tid >> 4, col = nb * 32 + (F.tid & 15); const size_t o = (size_t)row * DM + col; float* h = (float*)(sm + SM_H1);
            y1 += h[o]; y2 += h[o + 16]; h[o] = y1; h[o + 16] = y2; st1((bf16_t*)(sm + SM_H1B) + o, y1); st1((bf16_t*)(sm + SM_H1B) + o + 16, y2);
            const float s = sum16(y1 * y1 + y2 * y2); if ((F.tid & 15) == 0) ((float*)(sm + SM_SSQ))[2048 + row * 64 + nb] = s;
        }
    }
    SEAM(9);
    if (PHASE_ON(10) && IN(10)) {
        {
            pg8::Gemm g{(const bf16_t*)(ws + WS_H1B), (const bf16_t*)(ws + WS_WUP), MP, DFF, DM};
            pg8::StaticOrder S; S.init(MP, DFF, G, cid);
            EpiUp E{(const float*)(ws + WS_SSQ + 1 * MiB), (bf16_t*)(ws + WS_ACT)};
            pg8::gemm_phase<EpiUp, pg8::StaticOrder, true, true>(lds, g, S, E);
        }
        for (int nb = cid; nb < DFF / 32; nb += G) {
            const f32x16 a1 = skinny_partial((const bf16_t*)(sm + SM_H1B), DM, (const bf16_t*)(ws + WS_WUP), DM, nb, F.wave, F.lane);
            float y1, y2; skinny_reduce(a1, red, F.wave, F.lane, F.tid, y1, y2);
            const int row = F.tid >> 4, col = nb * 32 + (F.tid & 15); const float rs = rstd_n((const float*)(sm + SM_SSQ) + 2048 + row * 64, 64);
            y1 = fmaxf(y1 * rs, 0.f); y2 = fmaxf(y2 * rs, 0.f);
            st1((bf16_t*)(sm + SM_ACT) + (size_t)row * DFF + col, y1 * y1); st1((bf16_t*)(sm + SM_ACT) + (size_t)row * DFF + col + 16, y2 * y2);
        }
    }
    SEAM(10);
    if (PHASE_ON(11) && IN(11)) {
        {
            pg8::Gemm g{(const bf16_t*)(ws + WS_ACT), (const bf16_t*)(ws + WS_WDN), MP, DM, DFF};
            pg8::StaticOrder S; S.init(MP, DM, G, cid);
            EpiResid E{(const float*)(ws + WS_H1), out + O_Y, nullptr, (float*)(ws + WS_SSQ + 2 * MiB)};
            pg8::gemm_phase<EpiResid, pg8::StaticOrder, false, true>(lds, g, S, E);
        }
        for (int nb = cid; nb < DM / 32; nb += G) {
            const f32x16 a1 = skinny_partial((const bf16_t*)(sm + SM_ACT), DFF, (const bf16_t*)(ws + WS_WDN), DFF, nb, F.wave, F.lane);
            float y1, y2; skinny_reduce(a1, red, F.wave, F.lane, F.tid, y1, y2);
            const int row = F.tid >> 4, col = nb * 32 + (F.tid & 15); const size_t o = (size_t)row * DM + col; const float* h = (const float*)(sm + SM_H1);
            y1 += h[o]; y2 += h[o + 16]; out[O_YS + o] = y1; out[O_YS + o + 16] = y2;
            const float s = sum16(y1 * y1 + y2 * y2); if ((F.tid & 15) == 0) ((float*)(sm + SM_SSQ))[4096 + row * 64 + nb] = s;
        }
    }
    SEAM(11);
    if (PHASE_ON(12) && IN(12)) {
        const float* gf = (const float*)args.in[I_GFINAL];
        for (int row = F.vcu * NWAVES + F.wave; row < MP + MS; row += G * NWAVES) {
            if (row < MP) final_norm_row(out + O_Y + (size_t)row * DM, (const float*)(ws + WS_SSQ + 2 * MiB) + (size_t)row * 32, 32, gf, F.lane);
            else final_norm_row(out + O_YS + (size_t)(row - MP) * DM, (const float*)(sm + SM_SSQ) + 4096 + (row - MP) * 64, 64, gf, F.lane);
        }
    }
#undef IN
#undef SEAM
}

#ifndef MK_N_LAUNCHES
#define MK_N_LAUNCHES 1
#endif
extern "C" void kernel_launch(void* const* d_in, const int* in_sizes, int n_in, void* d_out, int out_size, void* d_ws, size_t ws_size, hipStream_t stream) {
    static int grid = 0;
    if (grid == 0) {
        if (n_in != 26 || ws_size < WS_END) { fprintf(stderr, "kernel_launch: expected 26 inputs and >= %zu bytes of workspace; got %d inputs, %zu bytes\n", (size_t)WS_END, n_in, ws_size); grid = -1; return; }
        int dev = 0, cus = 0, per_cu = 0;
        if (hipGetDevice(&dev) != hipSuccess || hipDeviceGetAttribute(&cus, hipDeviceAttributeMultiprocessorCount, dev) != hipSuccess) { grid = -1; return; }
        if (hipFuncSetAttribute((const void*)mega_fwd, hipFuncAttributeMaxDynamicSharedMemorySize, LDS_BYTES) != hipSuccess) { fprintf(stderr, "kernel_launch: hipFuncSetAttribute failed\n"); grid = -1; return; }
        if (hipOccupancyMaxActiveBlocksPerMultiprocessor(&per_cu, (const void*)mega_fwd, NWAVES * 64, LDS_BYTES) != hipSuccess || per_cu < 1)
            fprintf(stderr, "kernel_launch: occupancy query reports %d workgroups per CU\n", per_cu);
        (void)hipGetLastError();
        grid = cus;
    }
    if (grid < 0) return;
    if (hipMemsetAsync((char*)d_ws + WS_CTL, 0, CTL_ZERO_BYTES, stream) != hipSuccess) return;
    Args a{};
    for (int i = 0; i < 26; ++i) a.in[i] = d_in[i];
    a.out = (float*)d_out; a.ws = (unsigned char*)d_ws;
    if (MK_N_LAUNCHES == 1) { a.ph_lo = 0; a.ph_hi = N_PHASES; hipLaunchKernelGGL(mega_fwd, dim3(grid), dim3(NWAVES * 64), LDS_BYTES, stream, a); }
    else for (int p = 0; p < N_PHASES; ++p) { a.ph_lo = p; a.ph_hi = p + 1; hipLaunchKernelGGL(mega_fwd, dim3(grid), dim3(NWAVES * 64), LDS_BYTES, stream, a); }
    const hipError_t le = hipPeekAtLastError();
    if (le != hipSuccess) fprintf(stderr, "kernel_launch: launch failed: %s\n", hipGetErrorName(le));
}
```

```cpp
#include <hip/hip_runtime.h>
#include <cstdio>
#include <cstdint>

#define LAS __attribute__((address_space(3)))
#define GAS __attribute__((address_space(1)))
typedef unsigned short bf16_t;
typedef short bf16x8 __attribute__((ext_vector_type(8)));
typedef short s16x4 __attribute__((ext_vector_type(4)));
typedef float f32x2 __attribute__((ext_vector_type(2)));
typedef float f32x4 __attribute__((ext_vector_type(4)));
typedef float f32x16 __attribute__((ext_vector_type(16)));
typedef unsigned u32x2 __attribute__((ext_vector_type(2)));
typedef unsigned u32x4 __attribute__((ext_vector_type(4)));
typedef unsigned long long u64;

constexpr int DM = 2048, SEQ = 4096, MP = 8192, MS = 32, NIN = 10832, NV1 = 11008, DFF = 8192, MEMW = 512;
constexpr int PAST = 16384, NTPOS = 4100;
constexpr int SLEN = 16400;
constexpr float EPS = 1e-6f;
constexpr float QK_SCALE = 0.08838834764831845f;

constexpr size_t O_Y = 0, O_YS = 16777216, O_RSP = 16842752, O_KP = 17104896, O_VP = 19202048, O_IKP = 21299200, O_MK = 21823488, O_MV = 22085632,
                 O_RSS = 22347776, O_KS = 23396352, O_VS = 23404544, O_IKS = 23412736;

constexpr size_t MiB = 1u << 20, KiB = 1u << 10;
constexpr size_t WS_CTL = 0, CTL_ZERO_BYTES = 1 * MiB;
constexpr size_t WS_TAB = 1 * MiB;
constexpr size_t TAB_COS64 = 0, TAB_SIN64 = (size_t)NTPOS * 64 * 4, TAB_COS16 = 2 * TAB_SIN64, TAB_SIN16 = TAB_COS16 + (size_t)NTPOS * 16 * 4,
                 TAB_COS8 = TAB_SIN16 + (size_t)NTPOS * 16 * 4, TAB_SIN8 = TAB_COS8 + (size_t)NTPOS * 8 * 4;
static_assert(TAB_SIN8 + (size_t)NTPOS * 8 * 4 <= 3 * MiB, "tables");
constexpr size_t WS_SSQ = 4 * MiB;
constexpr size_t WS_WT1 = 8 * MiB;
constexpr size_t WS_WRO = 55 * MiB, WS_WDO = 59 * MiB, WS_WO = 63 * MiB, WS_WMQ = 71 * MiB, WS_WMO = 73 * MiB, WS_WUP = 75 * MiB, WS_WDN = 107 * MiB;
constexpr size_t WS_XN = 139 * MiB;
constexpr size_t WS_RQ = 173 * MiB, WS_RK = 189 * MiB, WS_RV = 205 * MiB, WS_RG = 221 * MiB;
constexpr size_t WS_DQ = 237 * MiB, WS_DK = 253 * MiB, WS_DV = 257 * MiB, WS_IQ = 261 * MiB, WS_IK = 277 * MiB, WS_IW = 278 * MiB;
constexpr size_t WS_GA = 279 * MiB, WS_GB = 311 * MiB;
constexpr size_t WS_SCORES = 343 * MiB;
constexpr size_t WS_KVC = 471 * MiB;
constexpr size_t WS_SPREV = 503 * MiB;
constexpr size_t WS_MASK = 519 * MiB;
constexpr size_t WS_RETY = 523 * MiB, WS_DSAO = 539 * MiB;
constexpr size_t WS_MERGED = 555 * MiB, WS_H1B = 587 * MiB, WS_QM = 619 * MiB, WS_OM = 627 * MiB, WS_MEMKB = 635 * MiB, WS_MEMVB = 638 * MiB;
constexpr size_t WS_SMP = 641 * MiB;
constexpr size_t WS_END = 665 * MiB;
constexpr size_t WS_T1 = WS_SCORES;
constexpr size_t WS_H1 = WS_RQ;
constexpr size_t WS_ACT = WS_SCORES;
constexpr size_t SM_XN = 0, SM_RQ = 512 * KiB, SM_RK = 1024 * KiB, SM_RV = 1536 * KiB, SM_RG = 2048 * KiB, SM_DQ = 2560 * KiB, SM_DK = 3072 * KiB, SM_DV = 3584 * KiB,
                 SM_IQ = 4096 * KiB, SM_IK = 4608 * KiB, SM_IW = 5120 * KiB, SM_GA = 5632 * KiB, SM_GB = 6144 * KiB, SM_RETY = 6656 * KiB, SM_DSAO = 7168 * KiB,
                 SM_MERGED = 7680 * KiB, SM_H1 = 8192 * KiB, SM_H1B = 8704 * KiB, SM_QM = 9216 * KiB, SM_OM = 9728 * KiB, SM_ACT = 10240 * KiB, SM_SIDX = 11264 * KiB,
                 SM_SSQ = 11776 * KiB  , SM_T1 = 12288 * KiB, SM_SCORE = 13 * MiB  ;

constexpr int CW_BAR = 4096;

constexpr int RING_BYTES = 131072, LDSCTL_OFF = RING_BYTES, MISC_OFF = LDSCTL_OFF + 320, LDS_BYTES = 147456;

__device__ __forceinline__ unsigned f2bf(float f) { unsigned u = __builtin_bit_cast(unsigned, f); return (u + 0x7fffu + ((u >> 16) & 1u)) >> 16; }
__device__ __forceinline__ unsigned pk2(float lo, float hi) { return f2bf(lo) | (f2bf(hi) << 16); }
__device__ __forceinline__ float bf2f(unsigned short b) { return __builtin_bit_cast(float, (unsigned)b << 16); }
__device__ __forceinline__ float bflo(unsigned w) { return __builtin_bit_cast(float, w << 16); }
__device__ __forceinline__ float bfhi(unsigned w) { return __builtin_bit_cast(float, w & 0xffff0000u); }
__device__ __forceinline__ float wave_sum(float v) {
#pragma unroll
    for (int o = 1; o < 64; o <<= 1) v += __shfl_xor(v, o);
    return v;
}
__device__ __forceinline__ float wave_max(float v) {
#pragma unroll
    for (int o = 1; o < 64; o <<= 1) v = fmaxf(v, __shfl_xor(v, o));
    return v;
}
__device__ __forceinline__ float sigmoidf_(float x) { return 1.0f / (1.0f + __expf(-x)); }
__device__ __forceinline__ float siluf_(float x) { return x / (1.0f + __expf(-x)); }
__device__ __forceinline__ int crow(int r, int hi) { return (r & 3) + 8 * (r >> 2) + 4 * hi; }
__device__ __forceinline__ float lg2g(int h) { return __log2f(1.0f - exp2f(-5.0f - (float)h)); }

__host__ __device__ inline int idx_e(int y) {
    const int n = (y >> 4) & 1, fq = (y >> 2) & 3, j = y & 3;
    return fq < 2 ? 8 * n + 4 * fq + j : 16 + 8 * n + 4 * (fq - 2) + j;
}
__host__ __device__ inline int win_real_col(int v) {
    const int tile = v >> 8, x8 = v & 255, bj = x8 >> 7, x = x8 & 127;
    if (tile < 8) { const int wc = x >> 5, n = (x >> 4) & 1, r = x & 15; return tile * 256 + bj * 128 + 64 * n + 16 * wc + r; }
    if (tile < 22) return v;
    if (tile < 26) { const int y = x & 63; return 5632 + (tile - 22) * 256 + bj * 128 + (x & 64) + (y < 32 ? idx_e(y) : y); }
    if (tile == 26) { if (x8 < 64) return 6656 + (x8 < 32 ? idx_e(x8) : x8); if (x8 < 80) return 6720 + (x8 - 64); return -1; }
    if (tile < 35) return 6736 + (v - 27 * 256);
    return 8784 + (v - 35 * 256);
}
namespace pg8 {
#define PG8_LAS __attribute__((address_space(3)))
typedef unsigned short bf16_t;
typedef short bf16x8 __attribute__((ext_vector_type(8)));
typedef float f32x4 __attribute__((ext_vector_type(4)));
typedef unsigned u32x4 __attribute__((ext_vector_type(4)));
constexpr int BM = 256, BK = 64, HALF = 128, HTB = HALF * BK * 2  , STAGE_BYTES = 8 * HTB, NXCD = 8, WGM = 8;

__host__ __device__ __forceinline__ int lds_byte(int r, int c) { const int st = (r >> 4) * 2 + (c >> 5), rr = r & 15, cc = c & 31, ob = rr * 64 + cc * 2; return st * 1024 + (ob ^ (((ob >> 9) & 1) << 5)); }
__host__ __device__ __forceinline__ void stage_rc(int b, int& R, int& C) { const int st = b / 1024, sb = b % 1024, swz = sb ^ (((sb >> 9) & 1) << 5); R = (st >> 1) * 16 + swz / 64; C = (st & 1) * 32 + (swz % 64) / 2; }
__host__ __device__ __forceinline__ int perm32(int rho) { const int n = rho >> 4, i = rho & 15; return 8 * (i >> 2) + 4 * n + (i & 3); }

struct Unit { int pm, pn; };
struct Gemm { const bf16_t* A; const bf16_t* Bt; int M, N, K; };

struct StaticOrder {
    int nM, nN, nwg, G, c;
    __host__ __device__ void init(int M, int N, int G_, int c_) { nM = M / BM; nN = N / BM; nwg = nM * nN; G = G_; c = c_; }
    __host__ __device__ bool next(int i, Unit& u) const {
        const long L = (long)i * G + c; if (L >= nwg) return false;
        int wgid = (int)L; { const int q = nwg / NXCD, r = nwg % NXCD, xcd = wgid % NXCD, off = wgid / NXCD; wgid = (xcd < r ? xcd * (q + 1) : r * (q + 1) + (xcd - r) * q) + off; }
        const int nig = WGM * nN, gid = wgid / nig, fm = gid * WGM, gsz = (nM - fm) < WGM ? (nM - fm) : WGM;
        u.pm = fm + ((wgid % nig) % gsz); u.pn = (wgid % nig) / gsz; return true;
    }
    __device__ __forceinline__ void a_ready(const Unit&) const {}
    __device__ __forceinline__ void done(const Unit&) const {}
};


template <class Epi, class Sched, bool ALIGN_EPI = false, bool SP2 = false>
__device__ __forceinline__ void gemm_phase(PG8_LAS unsigned char* lds, const Gemm g, const Sched& S, const Epi& E) {
    const int tid = threadIdx.x, wid = __builtin_amdgcn_readfirstlane(tid >> 6), lane = tid & 63, wr = wid >> 2, wc = wid & 3, fr = lane & 15, fq = lane >> 4;
    const int K = g.K, nt = K / BK;
    unsigned voffA[2], voffB[2];
#pragma unroll
    for (int i = 0; i < 2; ++i) { int R, C; stage_rc(tid * 16 + i * 8192, R, C); const int Rb = Epi::PERM ? ((R & ~31) + perm32(R & 31)) : R;
        voffA[i] = (unsigned)(R * K + C) * 2u; voffB[i] = (unsigned)(Rb * K + C) * 2u; }
    const size_t kstep = (size_t)(BK * 2);
    const size_t hstep = (size_t)HALF * K * 2;
    const size_t tstep = 2 * hstep;
    const unsigned ldsw = (unsigned)wid * 1024u;
    const int aoff = lds_byte(wr * 64 + fr, fq * 8), boff = lds_byte(wc * 32 + fr, fq * 8);
#define PG8_SA(b, h) (((b) * 2 + (h)) * HTB)
#define PG8_SB(b, h) ((4 + (b) * 2 + (h)) * HTB)
#define PG8_STAGE(bufoff, gbase, voff) do { _Pragma("unroll") for (int _i = 0; _i < 2; ++_i) \
        __builtin_amdgcn_global_load_lds((const unsigned*)((const char*)(gbase) + (voff)[_i]), (PG8_LAS unsigned*)(lds + (bufoff) + ldsw + _i * 8192), 16, 0, 0); } while (0)
#define PG8_LDA(dst, b, h) do { _Pragma("unroll") for (int m = 0; m < 4; ++m) _Pragma("unroll") for (int k = 0; k < 2; ++k) dst[m][k] = *(const PG8_LAS bf16x8*)(lds + PG8_SA(b, h) + aoff + m * 2048 + k * 1024); } while (0)
#define PG8_LDB(dst, b, h) do { _Pragma("unroll") for (int n = 0; n < 2; ++n) _Pragma("unroll") for (int k = 0; k < 2; ++k) dst[n][k] = *(const PG8_LAS bf16x8*)(lds + PG8_SB(b, h) + boff + n * 2048 + k * 1024); } while (0)
#define PG8_MMA(ai, bj, At, Bt) do { __builtin_amdgcn_s_setprio(1); _Pragma("unroll") for (int m = 0; m < 4; ++m) _Pragma("unroll") for (int n = 0; n < 2; ++n) _Pragma("unroll") for (int k = 0; k < 2; ++k) \
        acc[ai][bj][m][n] = __builtin_amdgcn_mfma_f32_16x16x32_bf16(Bt[n][k], At[m][k], acc[ai][bj][m][n], 0, 0, 0); __builtin_amdgcn_s_setprio(0); } while (0)
#define PG8_WAIT_V(n) asm volatile("s_waitcnt vmcnt(" #n ")" ::: "memory")
#define PG8_WAIT_L(n) asm volatile("s_waitcnt lgkmcnt(" #n ")" ::: "memory")
#define PG8_BAR __builtin_amdgcn_s_barrier()
#define PG8_SCHED __builtin_amdgcn_sched_barrier(0)
    Unit cur, nxt; int ui = 0;
    if (!S.next(0, cur)) return;
    f32x4 acc[2][2][4][2];
#pragma unroll
    for (int a = 0; a < 2; ++a)
#pragma unroll
        for (int b = 0; b < 2; ++b)
#pragma unroll
            for (int m = 0; m < 4; ++m)
#pragma unroll
                for (int n = 0; n < 2; ++n) acc[a][b][m][n] = (f32x4){0.f, 0.f, 0.f, 0.f};
    bf16x8 At[4][2], B0[2][2], B1[2][2];
    const char* cA = (const char*)g.A + (size_t)cur.pm * tstep; const char* cB = (const char*)g.Bt + (size_t)cur.pn * tstep;
    S.a_ready(cur);
    if constexpr (SP2) {
        PG8_STAGE(PG8_SB(0, 0), cB, voffB); PG8_STAGE(PG8_SB(0, 1), cB + hstep, voffB); PG8_STAGE(PG8_SA(0, 0), cA, voffA); PG8_STAGE(PG8_SA(0, 1), cA + hstep, voffA);
        if (wr == 1) PG8_BAR;
        PG8_WAIT_V(2); PG8_BAR;
        PG8_STAGE(PG8_SB(1, 0), cB + kstep, voffB); PG8_STAGE(PG8_SA(1, 0), cA + kstep, voffA); PG8_STAGE(PG8_SB(1, 1), cB + hstep + kstep, voffB);
        PG8_WAIT_V(6); PG8_BAR;
    } else {
        PG8_STAGE(PG8_SB(0, 0), cB, voffB); PG8_STAGE(PG8_SA(0, 0), cA, voffA); PG8_STAGE(PG8_SB(0, 1), cB + hstep, voffB); PG8_STAGE(PG8_SA(0, 1), cA + hstep, voffA);
        if (wr == 1) PG8_BAR;
        PG8_WAIT_V(4); PG8_BAR;
        PG8_STAGE(PG8_SB(1, 0), cB + kstep, voffB); PG8_STAGE(PG8_SA(1, 0), cA + kstep, voffA); PG8_STAGE(PG8_SB(1, 1), cB + hstep + kstep, voffB);
        PG8_WAIT_V(6); PG8_BAR;
    }
    for (;;) {
        const bool has_next = S.next(ui + 1, nxt);
        const char* nA = has_next ? (const char*)g.A + (size_t)nxt.pm * tstep : cA; const char* nB = has_next ? (const char*)g.Bt + (size_t)nxt.pn * tstep : cB;
        for (int t = 0; t < nt; t += 2) {
            const bool last = (t == nt - 2);
            const char* a1 = cA + (size_t)(t + 1) * kstep;
            const char* a2 = last ? nA : cA + (size_t)(t + 2) * kstep; const char* b2 = last ? nB : cB + (size_t)(t + 2) * kstep;
            const char* a3 = a2 + kstep; const char* b3 = b2 + kstep;
            if (last && has_next) S.a_ready(nxt);
            if constexpr (SP2) {
            PG8_LDB(B0, 0, 0); PG8_LDB(B1, 0, 1); PG8_SCHED; PG8_LDA(At, 0, 0); PG8_STAGE(PG8_SA(1, 1), a1 + hstep, voffA);
            PG8_WAIT_V(8); PG8_WAIT_L(0); PG8_BAR; PG8_MMA(0, 0, At, B0); PG8_MMA(0, 1, At, B1); PG8_BAR; PG8_SCHED;
            PG8_LDA(At, 0, 1); PG8_STAGE(PG8_SB(0, 0), b2, voffB); PG8_STAGE(PG8_SB(0, 1), b2 + hstep, voffB); PG8_STAGE(PG8_SA(0, 0), a2, voffA);
            PG8_WAIT_V(8); PG8_WAIT_L(0); PG8_BAR; PG8_MMA(1, 0, At, B0); PG8_MMA(1, 1, At, B1); PG8_BAR; PG8_SCHED;
            PG8_LDB(B0, 1, 0); PG8_LDB(B1, 1, 1); PG8_SCHED; PG8_LDA(At, 1, 0); PG8_STAGE(PG8_SA(0, 1), a2 + hstep, voffA);
            PG8_WAIT_V(8); PG8_WAIT_L(0); PG8_BAR; PG8_MMA(0, 0, At, B0); PG8_MMA(0, 1, At, B1); PG8_BAR; PG8_SCHED;
            PG8_LDA(At, 1, 1); PG8_STAGE(PG8_SB(1, 0), b3, voffB); PG8_STAGE(PG8_SB(1, 1), b3 + hstep, voffB); PG8_STAGE(PG8_SA(1, 0), a3, voffA);
            PG8_WAIT_V(8); PG8_WAIT_L(0); PG8_BAR; PG8_MMA(1, 0, At, B0); PG8_MMA(1, 1, At, B1); PG8_BAR; PG8_SCHED;
            } else {
            PG8_LDB(B0, 0, 0); PG8_SCHED; PG8_LDA(At, 0, 0); PG8_STAGE(PG8_SA(1, 1), a1 + hstep, voffA);
            PG8_WAIT_L(8); PG8_BAR; PG8_WAIT_L(0); PG8_MMA(0, 0, At, B0); PG8_BAR; PG8_SCHED;
            PG8_LDB(B1, 0, 1); PG8_STAGE(PG8_SB(0, 0), b2, voffB);
            PG8_BAR; PG8_WAIT_L(0); PG8_MMA(0, 1, At, B1); PG8_BAR;
            PG8_LDA(At, 0, 1); PG8_STAGE(PG8_SA(0, 0), a2, voffA);
            PG8_BAR; PG8_WAIT_L(0); PG8_MMA(1, 0, At, B0); PG8_BAR; PG8_SCHED;
            PG8_STAGE(PG8_SB(0, 1), b2 + hstep, voffB);
            PG8_WAIT_V(6); PG8_BAR; PG8_MMA(1, 1, At, B1); PG8_BAR;
            PG8_LDB(B0, 1, 0); PG8_SCHED; PG8_LDA(At, 1, 0); PG8_STAGE(PG8_SA(0, 1), a2 + hstep, voffA);
            PG8_WAIT_L(8); PG8_BAR; PG8_WAIT_L(0); PG8_MMA(0, 0, At, B0); PG8_BAR; PG8_SCHED;
            PG8_LDB(B1, 1, 1); PG8_STAGE(PG8_SB(1, 0), b3, voffB);
            PG8_BAR; PG8_WAIT_L(0); PG8_MMA(0, 1, At, B1); PG8_BAR;
            PG8_LDA(At, 1, 1); PG8_STAGE(PG8_SA(1, 0), a3, voffA);
            PG8_BAR; PG8_WAIT_L(0); PG8_MMA(1, 0, At, B0); PG8_BAR; PG8_SCHED;
            PG8_STAGE(PG8_SB(1, 1), b3 + hstep, voffB);
            PG8_WAIT_V(6); PG8_BAR; PG8_MMA(1, 1, At, B1); PG8_BAR;
            }
        }
        if constexpr (ALIGN_EPI) { if (wr == 0) PG8_BAR; }
        if constexpr (!Epi::AFTER_DRAIN) { E(acc, cur, wr, wc, fr, fq); S.done(cur); }
        if (!has_next) break;
#pragma unroll
        for (int a = 0; a < 2; ++a)
#pragma unroll
            for (int b = 0; b < 2; ++b)
#pragma unroll
                for (int m = 0; m < 4; ++m)
#pragma unroll
                    for (int n = 0; n < 2; ++n) acc[a][b][m][n] = (f32x4){0.f, 0.f, 0.f, 0.f};
        cur = nxt; cA = nA; cB = nB; ++ui;
        if constexpr (ALIGN_EPI) { if (wr == 1) PG8_BAR; }
    }
    PG8_WAIT_V(0);
    if constexpr (!ALIGN_EPI) { if (wr == 0) PG8_BAR; }
    PG8_BAR;
    if constexpr (Epi::AFTER_DRAIN) { E.fused(acc, cur, wr, wc, fr, fq, lds, wid, lane); S.done(cur); }
#undef PG8_SA
#undef PG8_SB
#undef PG8_STAGE
#undef PG8_LDA
#undef PG8_LDB
#undef PG8_MMA
#undef PG8_WAIT_V
#undef PG8_WAIT_L
#undef PG8_BAR
#undef PG8_SCHED
}
}
#define XB_TMO      128
#define XB_XCNT(j)  (256  + 64 * (j))
#define XB_XSUB(j)  (1280 + 64 * (j))
#define XB_XGEN(j)  (2304 + 64 * (j))
#define XB_TOP      3328
#define XB_TOPGEN   3392
#define XCD_BAR_WORDS 3456
#define XB_SPIN_CAP (1u << 18)

__device__ __forceinline__ unsigned xb_ld(unsigned* p)              { return __hip_atomic_load(p, __ATOMIC_RELAXED, __HIP_MEMORY_SCOPE_AGENT); }
__device__ __forceinline__ unsigned xb_add(unsigned* p, unsigned v) { return __hip_atomic_fetch_add(p, v, __ATOMIC_RELAXED, __HIP_MEMORY_SCOPE_AGENT); }
__device__ __forceinline__ unsigned xb_xcc_id() { return (unsigned)__builtin_amdgcn_s_getreg((3 << 11) | 20) & 0xFu; }
#define XB_SPIN(cond, bar) do { unsigned _sp = 0; while (cond) { __builtin_amdgcn_s_sleep(1); \
    if ((++_sp & 255u) == 0u) { if (xb_ld(&(bar)[XB_TMO])) break; if (_sp > XB_SPIN_CAP) { atomicAdd(&(bar)[XB_TMO], 1u); break; } } } } while (0)

struct XcdBarrier {
    unsigned* bar; unsigned x;
    volatile LAS unsigned* st;
};

__device__ __forceinline__ XcdBarrier xcd_barrier_post(unsigned* bar, volatile LAS unsigned* st) {
    XcdBarrier b; b.bar = bar; b.x = xb_xcc_id(); b.st = st;
    if (threadIdx.x == 0) (void)xb_add(&bar[XB_XCNT(b.x)], 1u);
    return b;
}
__device__ __forceinline__ void xcd_barrier_complete(unsigned* bar, unsigned x, unsigned& nloc, unsigned& nx) {
    const unsigned G = gridDim.x * gridDim.y * gridDim.z;
    unsigned sum, cnt, mine, sp = 0u;
    for (;;) {
        sum = 0u; cnt = 0u; mine = 0u;
#pragma unroll
        for (unsigned j = 0; j < 16; ++j) { const unsigned c = xb_ld(&bar[XB_XCNT(j)]); sum += c; cnt += (c > 0u) ? 1u : 0u; mine = (j == x) ? c : mine; }
        if (sum == G) break;
        __builtin_amdgcn_s_sleep(1);
        if ((++sp & 255u) == 0u) { if (xb_ld(&bar[XB_TMO])) break; if (sp > XB_SPIN_CAP) { atomicAdd(&bar[XB_TMO], 1u); break; } }
    }
    nloc = mine > 0u ? mine : 1u; nx = cnt > 0u ? cnt : 1u;
}

__device__ __forceinline__ void xcd_barrier(const XcdBarrier& b) {
    asm volatile("s_waitcnt vmcnt(0)" ::: "memory");
    __syncthreads();
    if (threadIdx.x == 0) {
        unsigned* bar = b.bar;
        __builtin_amdgcn_s_waitcnt(0);
        unsigned nloc = b.st[0], nx = b.st[1];
        if (nloc == 0u) { xcd_barrier_complete(bar, b.x, nloc, nx); b.st[0] = nloc; b.st[1] = nx; }
        const unsigned old = xb_add(&bar[XB_XSUB(b.x)], 1u);
        const unsigned gen = old / nloc;
        if (old + 1u == (gen + 1u) * nloc) {
            __builtin_amdgcn_fence(__ATOMIC_RELEASE, "agent");
            asm volatile("s_waitcnt vmcnt(0)" ::: "memory");
            const unsigned og = xb_add(&bar[XB_TOP], 1u);
            const unsigned tg = og / nx;
            if (og + 1u == (tg + 1u) * nx) xb_add(&bar[XB_TOPGEN], 1u);
            else XB_SPIN(xb_ld(&bar[XB_TOPGEN]) == tg, bar);
            __builtin_amdgcn_fence(__ATOMIC_ACQUIRE, "agent");
            xb_add(&bar[XB_XGEN(b.x)], 1u);
            asm volatile("s_waitcnt vmcnt(0)" ::: "memory");
        } else {
            XB_SPIN(xb_ld(&bar[XB_XGEN(b.x)]) == gen, bar);
            __builtin_amdgcn_fence(__ATOMIC_ACQUIRE, "agent");
            asm volatile("s_waitcnt vmcnt(0)" ::: "memory");
        }
    }
    __syncthreads();
}

typedef GAS unsigned gu32;
#define RLX_AGENT __ATOMIC_RELAXED, __HIP_MEMORY_SCOPE_AGENT
#define LDS_WAIT() asm volatile("s_waitcnt lgkmcnt(0)" ::: "memory")
#define VM_WAIT() asm volatile("s_waitcnt vmcnt(0)" ::: "memory")
constexpr int NWAVES = 8;

struct Frame {
    LAS unsigned char* lds;
    unsigned char* ws; float* out;
    const void* const* in;
    int tid, lane, wave, vcu, G;
};
struct Args { const void* in[26]; float* out; unsigned char* ws; int ph_lo, ph_hi; };

enum { I_XP = 0, I_XS, I_MEMP, I_CK, I_CV, I_CIK, I_STATE, I_CMK, I_CMV, I_PT, I_GMIX, I_WIN, I_GNRET, I_WRO, I_WDO, I_WO, I_GMEM, I_GMEMKV, I_WMQ, I_WMK, I_WMV, I_WMO, I_GMLP, I_WUP, I_WDN, I_GFINAL };

__device__ __forceinline__ void p0_transpose_item(const float* W, int ldw, int k0, int rc4, const float* g, bf16_t* WT, int ldt, int vrow0, LAS unsigned char* scr, int lane) {
    const int nq = lane & 15, kq = lane >> 4;
    const float* src = W + (size_t)(k0 + 16 * kq) * ldw + (rc4 < 0 ? 0 : rc4);
    f32x4 x[16];
#pragma unroll
    for (int i = 0; i < 16; ++i) x[i] = *(const GAS f32x4*)(src + (size_t)i * ldw);
    if (g) {
#pragma unroll
        for (int i = 0; i < 16; ++i) x[i] = x[i] * g[k0 + 16 * kq + i];
    }
    if (rc4 < 0) {
#pragma unroll
        for (int i = 0; i < 16; ++i) x[i] = (f32x4){0.f, 0.f, 0.f, 0.f};
    }
#pragma unroll
    for (int e = 0; e < 4; ++e) {
        u32x4 w0, w1;
        w0.x = pk2(x[0][e], x[1][e]); w0.y = pk2(x[2][e], x[3][e]); w0.z = pk2(x[4][e], x[5][e]); w0.w = pk2(x[6][e], x[7][e]);
        w1.x = pk2(x[8][e], x[9][e]); w1.y = pk2(x[10][e], x[11][e]); w1.z = pk2(x[12][e], x[13][e]); w1.w = pk2(x[14][e], x[15][e]);
        LAS unsigned char* row = scr + (4 * nq + e) * 128;
        *(LAS u32x4*)(row + (((2 * kq) ^ (nq & 7)) * 16)) = w0; *(LAS u32x4*)(row + (((2 * kq + 1) ^ (nq & 7)) * 16)) = w1;
    }
    LDS_WAIT(); asm volatile("" ::: "memory");
    const int c = lane & 7;
#pragma unroll
    for (int j = 0; j < 8; ++j) { const int n = (lane >> 3) + 8 * j; const u32x4 v = *(const LAS u32x4*)(scr + n * 128 + ((c ^ ((n >> 2) & 7)) * 16));
        *(GAS u32x4*)(WT + (size_t)(vrow0 + n) * ldt + k0 + 8 * c) = v; }
    LDS_WAIT(); asm volatile("" ::: "memory");
}
__device__ __forceinline__ void rms_row_to_bf16(const float* xrow, const float* g, bf16_t* orow, int lane) {
    const GAS f32x4* xr = (const GAS f32x4*)xrow + lane; const GAS f32x4* gr = (const GAS f32x4*)g + lane;
    f32x4 v[8]; float s = 0.f;
#pragma unroll
    for (int j = 0; j < 8; ++j) { v[j] = xr[64 * j]; s += (v[j].x * v[j].x + v[j].y * v[j].y) + (v[j].z * v[j].z + v[j].w * v[j].w); }
    const float rstd = 1.0f / sqrtf(wave_sum(s) * (1.0f / DM) + EPS);
    GAS u32x2* o8 = (GAS u32x2*)orow + lane;
#pragma unroll
    for (int j = 0; j < 8; ++j) { const f32x4 gg = gr[64 * j]; u32x2 w; w.x = pk2(v[j].x * rstd * gg.x, v[j].y * rstd * gg.y); w.y = pk2(v[j].z * rstd * gg.z, v[j].w * rstd * gg.w); o8[64 * j] = w; }
}
__device__ __forceinline__ void p0_prologue(Frame& F, const Args& A) {
    LAS unsigned char* scr = F.lds + F.wave * 8192;
    const int gw = F.vcu * NWAVES + F.wave, NGW = F.G * NWAVES, lane = F.lane, nq4 = 4 * (lane & 15);
    unsigned char* ws = F.ws;
    constexpr int I_IN = 32 * (12032 / 64);
    constexpr int I_RO = 16 * 32, I_DOO = 16 * 32, I_O = 32 * 32, I_MQ = 32 * 8, I_MO = 8 * 32, I_UP = 32 * 128, I_DN = 128 * 32;
    constexpr int NITEMS = I_IN + I_RO + I_DOO + I_O + I_MQ + I_MO + I_UP + I_DN;
    for (int it = gw; it < NITEMS; it += NGW) {
        int r = it;
        if (r < I_IN) { const int vg = r >> 5, kb = r & 31, v0 = vg * 64;
            if (v0 < NV1) p0_transpose_item((const float*)A.in[I_WIN], NIN, kb * 64, win_real_col(v0 + nq4), nullptr, (bf16_t*)(ws + WS_WT1), DM, v0, scr, lane);
            else if (v0 < NV1 + 512) p0_transpose_item((const float*)A.in[I_WMK], MEMW, kb * 64, v0 - NV1 + nq4, nullptr, (bf16_t*)(ws + WS_WT1), DM, v0, scr, lane);
            else p0_transpose_item((const float*)A.in[I_WMV], MEMW, kb * 64, v0 - NV1 - 512 + nq4, nullptr, (bf16_t*)(ws + WS_WT1), DM, v0, scr, lane);
            continue; } r -= I_IN;
        if (r < I_RO) { const int vg = r >> 4, kb = r & 15; p0_transpose_item((const float*)A.in[I_WRO], DM, kb * 64, vg * 64 + nq4, nullptr, (bf16_t*)(ws + WS_WRO), 1024, vg * 64, scr, lane); continue; } r -= I_RO;
        if (r < I_DOO) { const int vg = r >> 4, kb = r & 15; p0_transpose_item((const float*)A.in[I_WDO], DM, kb * 64, vg * 64 + nq4, nullptr, (bf16_t*)(ws + WS_WDO), 1024, vg * 64, scr, lane); continue; } r -= I_DOO;
        if (r < I_O) { const int vg = r >> 5, kb = r & 31; p0_transpose_item((const float*)A.in[I_WO], DM, kb * 64, vg * 64 + nq4, nullptr, (bf16_t*)(ws + WS_WO), DM, vg * 64, scr, lane); continue; } r -= I_O;
        if (r < I_MQ) { const int vg = r >> 5, kb = r & 31; p0_transpose_item((const float*)A.in[I_WMQ], MEMW, kb * 64, vg * 64 + nq4, (const float*)A.in[I_GMEM], (bf16_t*)(ws + WS_WMQ), DM, vg * 64, scr, lane); continue; } r -= I_MQ;
        if (r < I_MO) { const int vg = r >> 3, kb = r & 7; p0_transpose_item((const float*)A.in[I_WMO], DM, kb * 64, vg * 64 + nq4, nullptr, (bf16_t*)(ws + WS_WMO), MEMW, vg * 64, scr, lane); continue; } r -= I_MO;
        if (r < I_UP) { const int vg = r >> 5, kb = r & 31; p0_transpose_item((const float*)A.in[I_WUP], DFF, kb * 64, vg * 64 + nq4, (const float*)A.in[I_GMLP], (bf16_t*)(ws + WS_WUP), DM, vg * 64, scr, lane); continue; } r -= I_UP;
        { const int vg = r >> 7, kb = r & 127; p0_transpose_item((const float*)A.in[I_WDN], DM, kb * 64, vg * 64 + nq4, nullptr, (bf16_t*)(ws + WS_WDN), DFF, vg * 64, scr, lane); }
    }
    for (int m = gw; m < MP + 512 + MS; m += NGW) {
        if (m < MP) rms_row_to_bf16((const float*)A.in[I_XP] + (size_t)m * DM, (const float*)A.in[I_GMIX], (bf16_t*)(ws + WS_XN) + (size_t)m * DM, lane);
        else if (m < MP + 512) rms_row_to_bf16((const float*)A.in[I_MEMP] + (size_t)(m - MP) * DM, (const float*)A.in[I_GMEMKV], (bf16_t*)(ws + WS_XN) + (size_t)m * DM, lane);
        else rms_row_to_bf16((const float*)A.in[I_XS] + (size_t)(m - MP - 512) * DM, (const float*)A.in[I_GMIX], (bf16_t*)(ws + WS_SMP + SM_XN) + (size_t)(m - MP - 512) * DM, lane);
    }
    {
        const int gt = F.vcu * (NWAVES * 64) + F.tid, NGT = F.G * NWAVES * 64;
        float* c64 = (float*)(ws + WS_TAB + TAB_COS64); float* s64 = (float*)(ws + WS_TAB + TAB_SIN64);
        float* c16 = (float*)(ws + WS_TAB + TAB_COS16); float* s16 = (float*)(ws + WS_TAB + TAB_SIN16);
        float* c8 = (float*)(ws + WS_TAB + TAB_COS8); float* s8 = (float*)(ws + WS_TAB + TAB_SIN8);
        for (int e = gt; e < NTPOS * 88; e += NGT) {
            const int tp = e / 88, i = e % 88; const float pos = (float)(tp < SEQ ? tp : PAST + (tp - SEQ));
            float inv; float* cd; float* sd;
            if (i < 64) { inv = powf(10000.0f, -(float)i / 64.0f); cd = c64 + tp * 64 + i; sd = s64 + tp * 64 + i; }
            else if (i < 80) { inv = powf(500000.0f, -(float)(i - 64) / 16.0f); cd = c16 + tp * 16 + (i - 64); sd = s16 + tp * 16 + (i - 64); }
            else { inv = powf(500000.0f, -(float)(i - 80) / 8.0f); cd = c8 + tp * 8 + (i - 80); sd = s8 + tp * 8 + (i - 80); }
            const float ang = pos * inv; float sn, cs; sincosf(ang, &sn, &cs); *cd = cs; *sd = sn;
        }
        const float* cmk = (const float*)A.in[I_CMK]; const float* cmv = (const float*)A.in[I_CMV];
        bf16_t* kb = (bf16_t*)(ws + WS_MEMKB) + 2 * 256 * 512; bf16_t* vb = (bf16_t*)(ws + WS_MEMVB) + 2 * 256 * 512;
        for (int e = gt; e < 2 * 8 * 256 * 512 / 4; e += NGT) {
            const int half = 8 * 256 * 512 / 4; const bool isv = e >= half; const int j = isv ? e - half : e;
            const f32x4 x = *((const GAS f32x4*)(isv ? cmv : cmk) + j); u32x2 w; w.x = pk2(x.x, x.y); w.y = pk2(x.z, x.w);
            *((GAS u32x2*)(isv ? vb : kb) + j) = w;
        }
    }
}
struct OrderX : pg8::StaticOrder {
    int nextra, xm0, xn0, xn;
    __device__ void initx(int M, int N, int G_, int c_, int nextra_, int xm0_, int xn0_, int xn_) { init(M, N, G_, c_); nextra = nextra_; xm0 = xm0_; xn0 = xn0_; xn = xn_; }
    __device__ bool next(int i, pg8::Unit& u) const {
        const long L = (long)i * G + c;
        if (L < nwg) return pg8::StaticOrder::next(i, u);
        const int e = (int)(L - nwg); if (e >= nextra) return false;
        u.pm = xm0 + e / xn; u.pn = xn0 + e % xn; return true;
    }
};
struct OrderDual : pg8::StaticOrder {
    __device__ bool next(int i, pg8::Unit& u) const {
        if (i >= 2) return false; if (!pg8::StaticOrder::next(0, u)) return false;
        if (i == 1) { u.pm += 32; u.pn += 8; } return true;
    }
};

__device__ __forceinline__ f32x16 skinny_partial(const bf16_t* A, int lda, const bf16_t* Wt, int K, int nb, int wave, int lane) {
    const int r32 = lane & 31, hi = lane >> 5, kw = K / 8;
    const bf16_t* ap = A + (size_t)r32 * lda + wave * kw + 8 * hi; const bf16_t* bp = Wt + (size_t)(nb * 32 + r32) * K + wave * kw + 8 * hi;
    f32x16 acc = {};
    for (int k = 0; k < kw; k += 64) {
        bf16x8 a[4], b[4];
#pragma unroll
        for (int i = 0; i < 4; ++i) { a[i] = *(const GAS bf16x8*)(ap + k + 16 * i); b[i] = *(const GAS bf16x8*)(bp + k + 16 * i); }
#pragma unroll
        for (int i = 0; i < 4; ++i) acc = __builtin_amdgcn_mfma_f32_32x32x16_bf16(a[i], b[i], acc, 0, 0, 0);
    }
    return acc;
}
__device__ __forceinline__ void skinny_reduce(const f32x16& acc, LAS float* red, int wave, int lane, int tid, float& v1, float& v2) {
    const int r32 = lane & 31, hi = lane >> 5;
    __syncthreads();
#pragma unroll
    for (int r = 0; r < 16; ++r) red[wave * 1024 + crow(r, hi) * 32 + r32] = acc[r];
    __syncthreads();
    const int row = tid >> 4, c = tid & 15; v1 = 0.f; v2 = 0.f;
#pragma unroll
    for (int w = 0; w < 8; ++w) { v1 += red[w * 1024 + row * 32 + c]; v2 += red[w * 1024 + row * 32 + 16 + c]; }
}
__device__ __forceinline__ float sum16(float v) { v += __shfl_xor(v, 1); v += __shfl_xor(v, 2); v += __shfl_xor(v, 4); v += __shfl_xor(v, 8); return v; }

#define PB(off) ((bf16_t*)(ws + (off)))
#define PF(off) ((float*)(ws + (off)))
#define TABF(off) ((const float*)(ws + WS_TAB + (off)))
__device__ __forceinline__ void st_bf4(bf16_t* p, f32x4 v) { u32x2 w; w.x = pk2(v.x, v.y); w.y = pk2(v.z, v.w); *(GAS u32x2*)p = w; }

struct EpiIn {
    static constexpr bool PERM = false, AFTER_DRAIN = false;
    unsigned char* ws; float* out;
    __device__ __forceinline__ void operator()(const f32x4 (&acc)[2][2][4][2], const pg8::Unit& u, int wr, int wc, int fr, int fq) const {
        const int pn = u.pn; const int rowb = u.pm * 256 + wr * 64 + fr; const int x0 = 32 * wc + 4 * fq;
        size_t boff = 0, foff = 0, tcoff = 0, tsoff = 0; bool hasf = false; int ld = 1024, act = 0, deck = 0, tstr = 0, toff = 0, rsub = 0; bool rot = false;
        int c1[2] = {x0, 128 + x0}, c2[2] = {x0 + 16, 128 + x0 + 16}; float l2[2] = {0.f, 0.f};
        if (pn < 8) { boff = pn < 4 ? WS_RQ : WS_RK; deck = pn < 4 ? 1 : 2; tstr = 64; tcoff = TAB_COS64; tsoff = TAB_SIN64; rot = true; toff = 16 * wc + 4 * fq;
            c1[0] = ((pn & 3) * 2) * 128 + toff; c1[1] = c1[0] + 128; c2[0] = c1[0] + 64; c2[1] = c1[1] + 64; l2[0] = lg2g((pn & 3) * 2); l2[1] = lg2g((pn & 3) * 2 + 1); }
        else if (pn < 16) { boff = pn < 12 ? WS_RV : WS_RG; act = pn < 12 ? 0 : 1; const int cb = (pn & 3) * 256; c1[0] += cb; c1[1] += cb; c2[0] += cb; c2[1] += cb; }
        else if (pn < 22) { tstr = 16; tcoff = TAB_COS16; tsoff = TAB_SIN16; rot = (wc == 0) && pn != 21; toff = 4 * fq;
            if (pn < 20) { boff = WS_DQ; const int cb = (pn - 16) * 256; c1[0] += cb; c1[1] += cb; c2[0] += cb; c2[1] += cb; }
            else { boff = pn == 20 ? WS_DK : WS_DV; foff = pn == 20 ? O_KP : O_VP; hasf = true; ld = 256; } }
        else if (pn < 27) { tstr = 8; tcoff = TAB_COS8; tsoff = TAB_SIN8; const bool low = (wc & 1) == 0; rot = low && fq < 2; toff = 4 * (fq & 1);
            const int e0 = low ? (fq < 2 ? 4 * fq : 16 + 4 * (fq - 2)) : 32 + 4 * fq, e1 = low ? e0 + 8 : e0 + 16;
            if (pn < 26) { boff = WS_IQ; const int hb = ((pn - 22) * 4 + (wc >> 1)) * 64; c1[0] = hb + e0; c2[0] = hb + e1; c1[1] = hb + 128 + e0; c2[1] = hb + 128 + e1; }
            else { boff = WS_IK; foff = O_IKP; hasf = true; ld = 64; c1[0] = wc < 2 ? e0 : -1; c2[0] = e1; c1[1] = -1; } }
        else if (pn < 43) { const bool isb = pn >= 35; boff = isb ? WS_GB : WS_GA; act = 2; ld = 2048; const int cb = (pn - (isb ? 35 : 27)) * 256; c1[0] += cb; c1[1] += cb; c2[0] += cb; c2[1] += cb; }
        else { const bool isv = pn >= 45; boff = isv ? WS_MEMVB : WS_MEMKB; foff = isv ? O_MV : O_MK; hasf = true; ld = 512; rsub = MP; const int cb = ((pn - 43) & 1) * 256; c1[0] += cb; c1[1] += cb; c2[0] += cb; c2[1] += cb; }
        bf16_t* bd = (bf16_t*)(ws + boff); float* fd = out + foff; const float* tcs = (const float*)(ws + WS_TAB + tcoff) + toff; const float* tsn = (const float*)(ws + WS_TAB + tsoff) + toff;
        if (pn == 26 && wc == 2) {
#pragma unroll
            for (int ai = 0; ai < 2; ++ai)
#pragma unroll
                for (int m = 0; m < 4; ++m) *(GAS f32x4*)((float*)(ws + WS_IW) + (size_t)(rowb + ai * 128 + m * 16) * 16 + 4 * fq) = acc[ai][0][m][0];
        }
#pragma unroll
        for (int ai = 0; ai < 2; ++ai)
#pragma unroll
            for (int m = 0; m < 4; ++m) { const int row = rowb + ai * 128 + m * 16, tp = row & (SEQ - 1); const size_t ro = (size_t)(row - rsub) * ld;
                f32x4 cs = {1.f, 1.f, 1.f, 1.f}, sn = {0.f, 0.f, 0.f, 0.f};
                if (rot) { cs = *(const GAS f32x4*)(tcs + tp * tstr); sn = *(const GAS f32x4*)(tsn + tp * tstr); }
                const float cif = (float)((row & 127) + 1);
#pragma unroll
                for (int bj = 0; bj < 2; ++bj) { if (c1[bj] < 0) continue;
                    const f32x4 x1 = acc[ai][bj][m][0], x2 = acc[ai][bj][m][1];
                    f32x4 o1 = x1 * cs - x2 * sn, o2 = x2 * cs + x1 * sn;
                    if (deck) { const float dec = deck == 1 ? exp2f(cif * l2[bj]) : exp2f(-cif * l2[bj]) * QK_SCALE; o1 = o1 * dec; o2 = o2 * dec; }
                    if (act == 1) { o1.x = siluf_(o1.x); o1.y = siluf_(o1.y); o1.z = siluf_(o1.z); o1.w = siluf_(o1.w); o2.x = siluf_(o2.x); o2.y = siluf_(o2.y); o2.z = siluf_(o2.z); o2.w = siluf_(o2.w); }
                    else if (act == 2) { o1.x = sigmoidf_(o1.x); o1.y = sigmoidf_(o1.y); o1.z = sigmoidf_(o1.z); o1.w = sigmoidf_(o1.w); o2.x = sigmoidf_(o2.x); o2.y = sigmoidf_(o2.y); o2.z = sigmoidf_(o2.z); o2.w = sigmoidf_(o2.w); }
                    st_bf4(bd + ro + c1[bj], o1); st_bf4(bd + ro + c2[bj], o2);
                    if (hasf) { *(GAS f32x4*)(fd + ro + c1[bj]) = o1; *(GAS f32x4*)(fd + ro + c2[bj]) = o2; } }
                asm volatile("" ::: "memory"); }
    }
};

__device__ __forceinline__ void st1(bf16_t* p, float v) { *(GAS bf16_t*)p = (bf16_t)f2bf(v); }
__device__ __forceinline__ void epi_in_sample(unsigned char* ws, float* out, int row, int nb, int c, float v1, float v2) {
    const int pn = nb >> 3, bj = (nb >> 2) & 1, wc = nb & 3, t = row & 3, tp = SEQ + t, fq = c >> 2, j = c & 3;
    if (pn < 8) { const bool isk = pn >= 4; const int head = (pn & 3) * 2 + bj, i = 16 * wc + c; const float l2 = lg2g(head);
        const float cs = TABF(TAB_COS64)[tp * 64 + i], sn = TABF(TAB_SIN64)[tp * 64 + i], dec = isk ? exp2f(-(float)(t + 1) * l2) * QK_SCALE : exp2f((float)(t + 1) * l2);
        bf16_t* o = PB(WS_SMP + (isk ? SM_RK : SM_RQ)) + (size_t)row * 1024 + head * 128 + i;
        st1(o, (v1 * cs - v2 * sn) * dec); st1(o + 64, (v2 * cs + v1 * sn) * dec);
    } else if (pn < 16) { const bool isg = pn >= 12; bf16_t* o = PB(WS_SMP + (isg ? SM_RG : SM_RV)) + (size_t)row * 1024 + (pn & 3) * 256 + bj * 128 + 32 * wc + c;
        st1(o, isg ? siluf_(v1) : v1); st1(o + 16, isg ? siluf_(v2) : v2);
    } else if (pn < 22) { const bool isq = pn < 20, isv = pn == 21; const int ld = isq ? 1024 : 256; const size_t off = (size_t)row * ld + (isq ? (pn - 16) * 256 : 0) + bj * 128 + 32 * wc + c;
        float cs = 1.f, sn = 0.f; if (wc == 0 && !isv) { cs = TABF(TAB_COS16)[tp * 16 + c]; sn = TABF(TAB_SIN16)[tp * 16 + c]; }
        const float o1 = v1 * cs - v2 * sn, o2 = v2 * cs + v1 * sn; bf16_t* dst = PB(WS_SMP + (isq ? SM_DQ : (isv ? SM_DV : SM_DK)));
        st1(dst + off, o1); st1(dst + off + 16, o2);
        if (!isq) { float* fo = out + (isv ? O_VS : O_KS); fo[off] = o1; fo[off + 16] = o2; }
    } else if (pn < 27) {
        if (pn == 26 && (bj == 1 || wc > 2)) return;
        if (pn == 26 && wc == 2) { PF(WS_SMP + SM_IW)[row * 16 + c] = v1; return; }
        const bool low = (wc & 1) == 0; const bool rot = low && fq < 2;
        float cs = 1.f, sn = 0.f; if (rot) { cs = TABF(TAB_COS8)[tp * 8 + c]; sn = TABF(TAB_SIN8)[tp * 8 + c]; }
        const float o1 = v1 * cs - v2 * sn, o2 = v2 * cs + v1 * sn;
        const int e0 = (low ? (fq < 2 ? 4 * fq : 16 + 4 * (fq - 2)) : 32 + 4 * fq) + j, e1 = low ? e0 + 8 : e0 + 16;
        if (pn < 26) { bf16_t* o = PB(WS_SMP + SM_IQ) + (size_t)row * 1024 + ((pn - 22) * 4 + 2 * bj + (wc >> 1)) * 64; st1(o + e0, o1); st1(o + e1, o2); }
        else { st1(PB(WS_SMP + SM_IK) + row * 64 + e0, o1); st1(PB(WS_SMP + SM_IK) + row * 64 + e1, o2); out[O_IKS + row * 64 + e0] = o1; out[O_IKS + row * 64 + e1] = o2; }
    } else { const bool isb = pn >= 35; bf16_t* o = PB(WS_SMP + (isb ? SM_GB : SM_GA)) + (size_t)row * 2048 + (pn - (isb ? 35 : 27)) * 256 + bj * 128 + 32 * wc + c;
        st1(o, sigmoidf_(v1)); st1(o + 16, sigmoidf_(v2)); }
}
__device__ __forceinline__ void d1_unit(Frame& F, int b, int qb, int kb) {
    const int lane = F.lane, wave = F.wave, r32 = lane & 31, hi = lane >> 5, qs = wave & 3, kh = wave >> 2;
    const bf16_t* IQ = (const bf16_t*)(F.ws + WS_IQ); const bf16_t* IK = (const bf16_t*)(F.ws + WS_IK); const float* IW = (const float*)(F.ws + WS_IW);
    float* SC = (float*)(F.ws + WS_SCORES);
    LAS float* wl = (LAS float*)(F.lds) + wave * 512;
    const int q0 = b * SEQ + qb * 128 + qs * 32, k0 = b * SEQ + kb * 128 + kh * 64;
    __syncthreads();
    {
        const GAS f32x4* src = (const GAS f32x4*)(IW + (size_t)q0 * 16) + lane * 2;
        const f32x4 a = src[0], c = src[1]; const int q = lane >> 1, h0 = (lane & 1) * 8;
        wl[(h0 + 0) * 32 + q] = a.x; wl[(h0 + 1) * 32 + q] = a.y; wl[(h0 + 2) * 32 + q] = a.z; wl[(h0 + 3) * 32 + q] = a.w;
        wl[(h0 + 4) * 32 + q] = c.x; wl[(h0 + 5) * 32 + q] = c.y; wl[(h0 + 6) * 32 + q] = c.z; wl[(h0 + 7) * 32 + q] = c.w;
    }
    bf16x8 bk[2][4];
#pragma unroll
    for (int cb = 0; cb < 2; ++cb)
#pragma unroll
        for (int ks = 0; ks < 4; ++ks) bk[cb][ks] = *(const GAS bf16x8*)(IK + (size_t)(k0 + cb * 32 + r32) * 64 + ks * 16 + 8 * hi);
    const bf16_t* aq = IQ + (size_t)(q0 + r32) * 1024 + 8 * hi;
    bf16x8 an[4];
#pragma unroll
    for (int ks = 0; ks < 4; ++ks) an[ks] = *(const GAS bf16x8*)(aq + ks * 16);
    f32x16 s0 = {}, s1 = {};
    LDS_WAIT();
    for (int h = 0; h < 16; ++h) {
        bf16x8 a[4];
#pragma unroll
        for (int ks = 0; ks < 4; ++ks) a[ks] = an[ks];
        if (h < 15) {
#pragma unroll
            for (int ks = 0; ks < 4; ++ks) an[ks] = *(const GAS bf16x8*)(aq + (h + 1) * 64 + ks * 16);
        }
        f32x16 d0 = {}, d1 = {};
#pragma unroll
        for (int ks = 0; ks < 4; ++ks) { d0 = __builtin_amdgcn_mfma_f32_32x32x16_bf16(a[ks], bk[0][ks], d0, 0, 0, 0); d1 = __builtin_amdgcn_mfma_f32_32x32x16_bf16(a[ks], bk[1][ks], d1, 0, 0, 0); }
        f32x4 wv[4];
#pragma unroll
        for (int g = 0; g < 4; ++g) wv[g] = *(const LAS f32x4*)(wl + h * 32 + 8 * g + 4 * hi);
#pragma unroll
        for (int r = 0; r < 16; ++r) { const float w = wv[r >> 2][r & 3]; s0[r] = fmaf(fmaxf(d0[r], 0.f), w, s0[r]); s1[r] = fmaf(fmaxf(d1[r], 0.f), w, s1[r]); }
    }
#pragma unroll
    for (int r = 0; r < 16; ++r) { float* o = SC + (size_t)(q0 + crow(r, hi)) * SEQ + (kb * 128 + kh * 64 + r32); o[0] = s0[r]; o[32] = s1[r]; }
}

typedef short v4i16_t __attribute__((ext_vector_type(4)));
__device__ __forceinline__ bf16x8 tr_frag(const LAS bf16_t* T, int ld, int k0, int c0, int lane) {
    const LAS bf16_t* p = T + (k0 + 8 * (lane >> 5) + ((lane & 15) >> 2)) * ld + c0 + 16 * ((lane >> 4) & 1) + 4 * (lane & 3);
    const v4i16_t lo = __builtin_amdgcn_ds_read_tr16_b64_v4i16((LAS v4i16_t*)p);
    const v4i16_t hh = __builtin_amdgcn_ds_read_tr16_b64_v4i16((LAS v4i16_t*)(p + 4 * ld));
    return (bf16x8){lo[0], lo[1], lo[2], lo[3], hh[0], hh[1], hh[2], hh[3]};
}
constexpr int TLD = 160;
__device__ __forceinline__ void stage_tile128(const bf16_t* g, int gld, LAS bf16_t* T, int tid) {
    const int row = tid >> 2, q = tid & 3;
    const GAS u32x4* src = (const GAS u32x4*)(g + (size_t)row * gld + q * 32);
    const u32x4 a = src[0], b = src[1], c = src[2], d = src[3];
    LAS u32x4* dst = (LAS u32x4*)(T + row * TLD + q * 32);
    dst[0] = a; dst[1] = b; dst[2] = c; dst[3] = d;
}

__device__ __forceinline__ void r1_unit(Frame& F, int bh, int n) {
    const int lane = F.lane, wave = F.wave, r32 = lane & 31, hi = lane >> 5, b = bh >> 3, h = bh & 7;
    LAS bf16_t* Vt = (LAS bf16_t*)F.lds; LAS bf16_t* Kt = Vt + 128 * TLD;
    const size_t row0 = (size_t)b * SEQ + n * 128;
    __syncthreads();
    stage_tile128((const bf16_t*)(F.ws + WS_RV) + row0 * 1024 + h * 128, 1024, Vt, F.tid);
    stage_tile128((const bf16_t*)(F.ws + WS_RK) + row0 * 1024 + h * 128, 1024, Kt, F.tid);
    __syncthreads();
    const int dvb = wave & 3, dkh = wave >> 2;
    f32x16 acc0 = {}, acc1 = {};
#pragma unroll
    for (int ks = 0; ks < 8; ++ks) {
        const bf16x8 a = tr_frag(Vt, TLD, 16 * ks, 32 * dvb, lane);
        const bf16x8 b0 = tr_frag(Kt, TLD, 16 * ks, 64 * dkh, lane), b1 = tr_frag(Kt, TLD, 16 * ks, 64 * dkh + 32, lane);
        acc0 = __builtin_amdgcn_mfma_f32_32x32x16_bf16(a, b0, acc0, 0, 0, 0); acc1 = __builtin_amdgcn_mfma_f32_32x32x16_bf16(a, b1, acc1, 0, 0, 0);
    }
    float* o = (float*)(F.ws + WS_KVC) + ((size_t)bh * 32 + n) * 16384;
#pragma unroll
    for (int r = 0; r < 16; ++r) { float* p = o + (32 * dvb + crow(r, hi)) * 128 + 64 * dkh + r32; p[0] = acc0[r]; p[32] = acc1[r]; }
}

__device__ __forceinline__ void s1_unit(Frame& F, const Args& A, int b, int c) {
    const int lane = F.lane, wave = F.wave, r32 = lane & 31, hi = lane >> 5;
    const bf16_t* IQ = (const bf16_t*)(F.ws + WS_SMP + SM_IQ); const float* IW = (const float*)(F.ws + WS_SMP + SM_IW);
    const float* CIK = (const float*)A.in[I_CIK]; const int* PT = (const int*)A.in[I_PT];
    float* SS = (float*)(F.ws + WS_SMP + SM_SCORE);
    const int s0 = c * 512 + wave * 64;
    const int page = PT[b * 128 + (s0 >> 7)];
    const float* kbase = CIK + ((size_t)page * 128 + (s0 & 127)) * 64;
    bf16x8 bk[2][4];
#pragma unroll
    for (int cb = 0; cb < 2; ++cb)
#pragma unroll
        for (int ks = 0; ks < 4; ++ks) { const GAS f32x4* p = (const GAS f32x4*)(kbase + (size_t)(cb * 32 + r32) * 64 + ks * 16 + 8 * hi); const f32x4 x = p[0], y = p[1];
            u32x4 w; w.x = pk2(x.x, x.y); w.y = pk2(x.z, x.w); w.z = pk2(y.x, y.y); w.w = pk2(y.z, y.w); bk[cb][ks] = __builtin_bit_cast(bf16x8, w); }
#pragma unroll
    for (int rb = 0; rb < 2; ++rb) {
        const bf16_t* ap = IQ + (size_t)(b * 4 + 2 * rb + (r32 >> 4)) * 1024 + (r32 & 15) * 64 + 8 * hi;
        f32x16 d0 = {}, d1 = {};
#pragma unroll
        for (int ks = 0; ks < 4; ++ks) { const bf16x8 a = *(const GAS bf16x8*)(ap + ks * 16);
            d0 = __builtin_amdgcn_mfma_f32_32x32x16_bf16(a, bk[0][ks], d0, 0, 0, 0); d1 = __builtin_amdgcn_mfma_f32_32x32x16_bf16(a, bk[1][ks], d1, 0, 0, 0); }
        float p00 = 0.f, p01 = 0.f, p10 = 0.f, p11 = 0.f;
#pragma unroll
        for (int r = 0; r < 16; ++r) { const int row = crow(r, hi), tl = row >> 4, h = row & 15; const float w = IW[(b * 4 + 2 * rb + tl) * 16 + h];
            const float e0 = fmaxf(d0[r], 0.f) * w, e1 = fmaxf(d1[r], 0.f) * w; if (r < 8) { p00 += e0; p10 += e1; } else { p01 += e0; p11 += e1; } }
        p00 += __shfl_xor(p00, 32); p01 += __shfl_xor(p01, 32); p10 += __shfl_xor(p10, 32); p11 += __shfl_xor(p11, 32);
        float* o = SS + (size_t)(b * 4 + 2 * rb + hi) * SLEN + s0 + r32;
        o[0] = hi ? p01 : p00; o[32] = hi ? p11 : p10;
    }
}
__device__ __forceinline__ void s1_tail(Frame& F, int b) {
    const int lane = F.lane; const bf16_t* IQ = (const bf16_t*)(F.ws + WS_SMP + SM_IQ); const bf16_t* IK = (const bf16_t*)(F.ws + WS_SMP + SM_IK);
    const float* IW = (const float*)(F.ws + WS_SMP + SM_IW); float* SS = (float*)(F.ws + WS_SMP + SM_SCORE);
    const int t = lane >> 4, tk = (lane >> 2) & 3, hq = lane & 3; float sc = 0.f;
    for (int hh = 0; hh < 4; ++hh) { const int h = hq * 4 + hh; float d = 0.f;
        for (int e = 0; e < 64; ++e) d += bf2f(IQ[(size_t)(b * 4 + t) * 1024 + h * 64 + e]) * bf2f(IK[(b * 4 + tk) * 64 + e]);
        sc += fmaxf(d, 0.f) * IW[(b * 4 + t) * 16 + h]; }
    sc += __shfl_xor(sc, 1); sc += __shfl_xor(sc, 2);
    if (hq == 0) SS[(size_t)(b * 4 + t) * SLEN + PAST + tk] = tk <= t ? sc : -INFINITY;
}
__device__ __forceinline__ unsigned fkey(float f) { const unsigned u = __builtin_bit_cast(unsigned, f); return (u & 0x80000000u) ? ~u : (u | 0x80000000u); }
__device__ __forceinline__ int wave_isum(int v) {
#pragma unroll
    for (int o = 1; o < 64; o <<= 1) v += __shfl_xor(v, o);
    return v;
}
__device__ __forceinline__ int popc64(u64 m) { return __builtin_popcountll(m); }
__device__ __forceinline__ int lane_rank(u64 m) { return (int)__builtin_amdgcn_mbcnt_hi((unsigned)(m >> 32), __builtin_amdgcn_mbcnt_lo((unsigned)m, 0u)); }

template <int I> struct D2Step {
    static __device__ __forceinline__ void run(const unsigned (&key)[64], unsigned tau, int need, int& taken, unsigned& wlo, unsigned& whi) {
        const bool gt = key[I] > tau, eq = key[I] == tau; const u64 em = __ballot(eq);
        const bool sel = gt || (eq && (taken + lane_rank(em) < need));
        taken += popc64(em);
        const u64 m = __ballot(sel); const unsigned mlo = (unsigned)m, mhi = (unsigned)(m >> 32);
        asm volatile("s_nop 3\n\tv_writelane_b32 %0, %1, %2" : "+v"(wlo) : "s"(mlo), "n"(I));
        asm volatile("s_nop 3\n\tv_writelane_b32 %0, %1, %2" : "+v"(whi) : "s"(mhi), "n"(I));
        D2Step<I + 1>::run(key, tau, need, taken, wlo, whi);
    }
};
template <> struct D2Step<64> { static __device__ __forceinline__ void run(const unsigned (&)[64], unsigned, int, int&, unsigned&, unsigned&) {} };

__device__ __forceinline__ int wave_isum_dpp(int v) {
    v += __builtin_amdgcn_update_dpp(0, v, 0xB1, 0xF, 0xF, true);
    v += __builtin_amdgcn_update_dpp(0, v, 0x4E, 0xF, 0xF, true);
    v += __builtin_amdgcn_update_dpp(0, v, 0x141, 0xF, 0xF, true);
    v += __builtin_amdgcn_update_dpp(0, v, 0x140, 0xF, 0xF, true);
    return __builtin_amdgcn_readlane(v, 0) + __builtin_amdgcn_readlane(v, 16) + __builtin_amdgcn_readlane(v, 32) + __builtin_amdgcn_readlane(v, 48);
}
__device__ __forceinline__ void d2_row(Frame& F, int row) {
    const int lane = F.lane, t = row & (SEQ - 1);
    const float* sc = (const float*)(F.ws + WS_SCORES) + (size_t)row * SEQ;
    u64* mo = (u64*)(F.ws + WS_MASK) + (size_t)row * 64;
    if (t < 256) {
        const int lo = lane * 64; const u64 myword = (t >= lo + 63) ? ~0ull : (t < lo ? 0ull : ((2ull << (t - lo)) - 1ull));
        mo[lane] = myword; return;
    }
    unsigned key[64];
    const int nfull = (t >> 6) + 1;
#pragma unroll
    for (int i = 0; i < 32; ++i) key[i] = __builtin_bit_cast(unsigned, sc[i * 64 + lane]);
#pragma unroll
    for (int i = 0; i < 32; ++i) asm volatile("" : "+v"(key[i]));
    if (nfull > 32) {
#pragma unroll
        for (int i = 32; i < 64; ++i) key[i] = __builtin_bit_cast(unsigned, sc[i * 64 + lane]);
#pragma unroll
        for (int i = 32; i < 64; ++i) asm volatile("" : "+v"(key[i]));
    } else {
#pragma unroll
        for (int i = 32; i < 64; ++i) key[i] = 0xff800000u;
    }
    unsigned lsb0 = 0u, lsb1 = 0u;
#pragma unroll
    for (int i = 0; i < 64; ++i) { const int s = i * 64 + lane; unsigned k = fkey(__builtin_bit_cast(float, key[i])); k = s <= t ? k : 0u;
        if (i < 32) lsb0 |= (k & 1u) << i; else lsb1 |= (k & 1u) << (i - 32); key[i] = k >> 1; }
    unsigned tau = 0u;
    for (int bit = 30; bit >= 0; --bit) {
        const unsigned cand = tau | (1u << bit); unsigned b0 = 0u, b1 = 0u;
#pragma unroll
        for (int i = 0; i < 32; ++i) { b0 = __builtin_amdgcn_alignbit(b0, key[i] - cand, 31); b1 = __builtin_amdgcn_alignbit(b1, key[i + 32] - cand, 31); }
        const int cnt = 4096 - wave_isum_dpp(__builtin_popcount(b0) + __builtin_popcount(b1));
        if (cnt >= 256) tau = cand;
        if (cnt == 256) break;
    }
#pragma unroll
    for (int i = 0; i < 64; ++i) key[i] = (key[i] << 1) | (((i < 32 ? lsb0 : lsb1) >> (i & 31)) & 1u);
    unsigned tau32 = tau << 1;
    { const unsigned c1 = tau32 | 1u; int c = 0;
#pragma unroll
      for (int i = 0; i < 64; ++i) c += (key[i] >= c1) ? 1 : 0;
      if (wave_isum_dpp(c) >= 256) tau32 = c1; }
    int cgt = 0;
    { int c = 0;
#pragma unroll
      for (int i = 0; i < 64; ++i) c += (key[i] > tau32) ? 1 : 0;
      cgt = wave_isum_dpp(c); }
    unsigned wlo = 0u, whi = 0u;
    const int need = 256 - cgt; int taken = 0;
    unsigned tau2 = tau32; asm volatile("" : "+v"(tau2));
    D2Step<0>::run(key, tau2, need, taken, wlo, whi);
    mo[lane] = ((u64)whi << 32) | wlo;
}

__device__ __forceinline__ void r2_scan(Frame& F) {
    const int gt = F.vcu * (NWAVES * 64) + F.tid;
    if (gt >= 131072) return;
    const int e = gt * 2, bh = e >> 14, off = e & 16383, h = bh & 7;
    const float cdec = exp2f(128.0f * lg2g(h));
    const float* kv = (const float*)(F.ws + WS_KVC) + (size_t)bh * 32 * 16384 + off;
    bf16_t* sp = (bf16_t*)(F.ws + WS_SPREV) + (size_t)bh * 32 * 16384 + off;
    float s0 = 0.f, s1 = 0.f; f32x2 k[32];
#pragma unroll
    for (int n = 0; n < 32; ++n) k[n] = *(const GAS f32x2*)(kv + (size_t)n * 16384);
#pragma unroll
    for (int n = 0; n < 32; ++n) {
        *(GAS unsigned*)(sp + (size_t)n * 16384) = pk2(s0, s1);
        s0 = cdec * (s0 + k[n].x); s1 = cdec * (s1 + k[n].y);
    }
    float* o = F.out + O_RSP + (size_t)bh * 16384; const int dv = off >> 7, dk = off & 127;
    o[dk * 128 + dv] = s0; o[(dk + 1) * 128 + dv] = s1;
}

__device__ __forceinline__ void s2_row(Frame& F, int q) {
    const int lane = F.lane, wave = F.wave, t = q & 3, n = PAST + t + 1;
    const float* sc = (const float*)(F.ws + WS_SMP + SM_SCORE) + (size_t)q * SLEN;
    int* so = (int*)(F.ws + WS_SMP + SM_SIDX) + q * 256;
    LAS int* cnts = (LAS int*)F.lds;
    unsigned key[33]; const int base = wave * 2112;
#pragma unroll
    for (int i = 0; i < 33; ++i) key[i] = __builtin_bit_cast(unsigned, sc[base + i * 64 + lane]);
#pragma unroll
    for (int i = 0; i < 33; ++i) asm volatile("" : "+v"(key[i]));
#pragma unroll
    for (int i = 0; i < 33; ++i) { const int s = base + i * 64 + lane; const unsigned k = fkey(__builtin_bit_cast(float, key[i])); key[i] = s < n ? k : 0u; }
    __syncthreads();
    unsigned tau = 0u;
    for (int bit = 31; bit >= 0; --bit) {
        const unsigned cand = tau | (1u << bit); int c = 0;
#pragma unroll
        for (int i = 0; i < 33; ++i) c += (key[i] >= cand) ? 1 : 0;
        const int cnt = wave_isum(c);
        LAS int* cb = cnts + (bit & 1) * 8;
        if (lane == 0) cb[wave] = cnt;
        __syncthreads();
        int tot = 0;
#pragma unroll
        for (int w = 0; w < 8; ++w) tot += cb[w];
        if (tot >= 256) tau = cand;
    }
    int cgt = 0, ceq = 0;
#pragma unroll
    for (int i = 0; i < 33; ++i) { cgt += (key[i] > tau) ? 1 : 0; ceq += (key[i] == tau) ? 1 : 0; }
    cgt = wave_isum(cgt); ceq = wave_isum(ceq);
    __syncthreads();
    if (lane == 0) { cnts[16 + wave] = cgt; cnts[32 + wave] = ceq; }
    __syncthreads();
    int gbase = 0, ebase = 0, gtot = 0;
#pragma unroll
    for (int w = 0; w < 8; ++w) { const int g = cnts[16 + w], e = cnts[32 + w]; if (w < wave) { gbase += g; ebase += e; } gtot += g; }
    const int need = 256 - gtot;
    int goff = gbase, eoff = ebase;
    unsigned tau2 = tau; asm volatile("" : "+v"(tau2));
#pragma unroll
    for (int i = 0; i < 33; ++i) {
        const int s = base + i * 64 + lane; const bool gt = key[i] > tau2, eq = key[i] == tau2;
        const u64 gm = __ballot(gt), em = __ballot(eq);
        if (gt) so[goff + lane_rank(gm)] = s;
        if (eq) { const int r = eoff + lane_rank(em); if (r < need) so[gtot + r] = s; }
        goff += popc64(gm); eoff += popc64(em);
        __builtin_amdgcn_sched_barrier(0);
    }
}
namespace fa {
constexpr int KVBLK = 64;
constexpr float SCALE = QK_SCALE;
constexpr size_t SHM_V = KVBLK * 128 * 2, SHM_K = KVBLK * 128 * 2;
constexpr int OFF_V = 0, OFF_K = 2 * SHM_V, OFF_WS = 2 * SHM_V + 2 * SHM_K;
#define KSWZ(row, colB) ((row) * 256 + ((colB) ^ (((row) & 7) << 4)))
#define SBAR() __builtin_amdgcn_sched_barrier(0)
__device__ __forceinline__ unsigned cvtpk(float lo, float hi) { unsigned r; asm volatile("v_cvt_pk_bf16_f32 %0, %1, %2" : "=v"(r) : "v"(lo), "v"(hi)); return r; }
__device__ __forceinline__ int v_st(int k, int c) { const int kk = (k & ~0xC) | ((k & 4) << 1) | ((k & 8) >> 1); return ((kk >> 3) * 4 + (c >> 5)) * 512 + ((kk & 7) * 32 + (c & 31)) * 2; }
__device__ __forceinline__ int v_rd_base(int lane) { return ((lane & 3) << 3) | (((lane >> 2) & 3) << 6) | (((lane >> 4) & 1) << 5) | (((lane >> 5) & 1) << 8); }
constexpr int v_rd_off(int d0, int ks, int half) { return d0 * 512 + ks * 4096 + half * 2048; }
template <int OFF> __device__ __forceinline__ s16x4 tr_read(int vb) { s16x4 r; asm volatile("ds_read_b64_tr_b16 %0, %1 offset:%2" : "=&v"(r) : "v"(vb), "i"(OFF) : "memory"); return r; }
template <int D0> __device__ __forceinline__ void pv_one(f32x16& od, int vb, bf16x8 pa0, bf16x8 pa1, bf16x8 pa2, bf16x8 pa3) {
    const s16x4 l0 = tr_read<v_rd_off(D0, 0, 0)>(vb), h0 = tr_read<v_rd_off(D0, 0, 1)>(vb), l1 = tr_read<v_rd_off(D0, 1, 0)>(vb), h1 = tr_read<v_rd_off(D0, 1, 1)>(vb);
    const s16x4 l2 = tr_read<v_rd_off(D0, 2, 0)>(vb), h2 = tr_read<v_rd_off(D0, 2, 1)>(vb), l3 = tr_read<v_rd_off(D0, 3, 0)>(vb), h3 = tr_read<v_rd_off(D0, 3, 1)>(vb);
    asm volatile("s_waitcnt lgkmcnt(0)" ::: "memory"); SBAR();
#define PK(L, H) (bf16x8){L[0], L[1], L[2], L[3], H[0], H[1], H[2], H[3]}
    od = __builtin_amdgcn_mfma_f32_32x32x16_bf16(pa0, PK(l0, h0), od, 0, 0, 0);
    od = __builtin_amdgcn_mfma_f32_32x32x16_bf16(pa1, PK(l1, h1), od, 0, 0, 0);
    od = __builtin_amdgcn_mfma_f32_32x32x16_bf16(pa2, PK(l2, h2), od, 0, 0, 0);
    od = __builtin_amdgcn_mfma_f32_32x32x16_bf16(pa3, PK(l3, h3), od, 0, 0, 0);
#undef PK
}
__device__ __forceinline__ void pv_d0(f32x16* o, int vb, bf16x8 pa0, bf16x8 pa1, bf16x8 pa2, bf16x8 pa3) {
    pv_one<0>(o[0], vb, pa0, pa1, pa2, pa3); pv_one<1>(o[1], vb, pa0, pa1, pa2, pa3); pv_one<2>(o[2], vb, pa0, pa1, pa2, pa3); pv_one<3>(o[3], vb, pa0, pa1, pa2, pa3);
}
__device__ __forceinline__ void qkt(f32x16& p0, f32x16& p1, const LAS char* Ks, const bf16x8* qr, int r32, int hi) {
    p0 = f32x16{}; p1 = f32x16{};
#pragma unroll
    for (int d0 = 0; d0 < 8; ++d0) { const int cb = (d0 * 16 + hi * 8) * 2;
        const bf16x8 b0 = *(const LAS bf16x8*)(Ks + KSWZ(r32, cb)); const bf16x8 b1 = *(const LAS bf16x8*)(Ks + KSWZ(32 + r32, cb));
        p0 = __builtin_amdgcn_mfma_f32_32x32x16_bf16(b0, qr[d0], p0, 0, 0, 0); p1 = __builtin_amdgcn_mfma_f32_32x32x16_bf16(b1, qr[d0], p1, 0, 0, 0); }
}
__device__ __forceinline__ float softmax_tile(f32x16& p0, f32x16& p1, float& m_reg, float& l_reg, bf16x8& pa0, bf16x8& pa1, bf16x8& pa2, bf16x8& pa3) {
    constexpr float C = SCALE * 1.4426950408889634f;
    float pmax = p0[0];
#pragma unroll
    for (int r = 1; r < 16; ++r) pmax = fmaxf(pmax, p0[r]);
#pragma unroll
    for (int r = 0; r < 16; ++r) pmax = fmaxf(pmax, p1[r]);
    { auto rr = __builtin_amdgcn_permlane32_swap(__float_as_uint(pmax), __float_as_uint(pmax), false, false); pmax = fmaxf(__uint_as_float(rr[0]), __uint_as_float(rr[1])); }
    float alpha = 1.f;
    if (!__all(pmax <= m_reg)) { const float mn = fmaxf(m_reg, pmax); alpha = __builtin_amdgcn_exp2f((m_reg - mn) * C); m_reg = mn; }
    const float mnC = -m_reg * C;
#pragma unroll
    for (int r = 0; r < 16; ++r) { p0[r] = __builtin_amdgcn_exp2f(fmaf(p0[r], C, mnC)); p1[r] = __builtin_amdgcn_exp2f(fmaf(p1[r], C, mnC)); }
    float ps = 0.f;
#pragma unroll
    for (int r = 0; r < 16; ++r) ps += p0[r] + p1[r];
    { auto rr = __builtin_amdgcn_permlane32_swap(__float_as_uint(ps), __float_as_uint(ps), false, false); ps = __uint_as_float(rr[0]) + __uint_as_float(rr[1]); }
    l_reg = l_reg * alpha + ps;
#define PK4(P, BASE, OUT) do { unsigned a0 = cvtpk(P[BASE + 0], P[BASE + 1]), a1 = cvtpk(P[BASE + 2], P[BASE + 3]);   \
    unsigned b0 = cvtpk(P[BASE + 4], P[BASE + 5]), b1 = cvtpk(P[BASE + 6], P[BASE + 7]);                              \
    auto r0 = __builtin_amdgcn_permlane32_swap(a0, b0, false, false); auto r1 = __builtin_amdgcn_permlane32_swap(a1, b1, false, false); \
    u32x4 w = {r0[0], r1[0], r0[1], r1[1]}; OUT = __builtin_bit_cast(bf16x8, w); } while (0)
    PK4(p0, 0, pa0); PK4(p0, 8, pa1); PK4(p1, 0, pa2); PK4(p1, 8, pa3);
#undef PK4
    return alpha;
}

template <bool MASKED>
__device__ __forceinline__ void attn_wg(const bf16_t* qrow, const bf16_t* Kh, const bf16_t* Vh, int ldk, int nt, int ntw, const u64* mrow,
                                        bf16_t* orow0, int ldo, LAS char* lds, int tid) {
    const int wid = tid >> 6, lane = tid & 63, r32 = lane & 31, hi = lane >> 5;
    LAS char* V_lds = lds + OFF_V; LAS char* K_lds = lds + OFF_K;
    LAS float* wsf = (LAS float*)(lds + OFF_WS) + wid * 64;
    float m_reg = -1e30f, l_reg = 0.f; f32x16 o[4] = {}; bf16x8 qr[8];
#pragma unroll
    for (int d0 = 0; d0 < 8; ++d0) qr[d0] = *(const GAS bf16x8*)(qrow + d0 * 16);
    const int sr = tid >> 4, sc = (tid & 15) * 8, vst0 = v_st(sr, sc), vst1 = v_st(32 + sr, sc);
    const int vb0 = (int)(uintptr_t)V_lds + v_rd_base(lane);
    bf16x8 vs0, vs1, ks0, ks1;
#define SLOAD(k0) do { vs0 = *(const GAS bf16x8*)(Vh + (size_t)((k0) + sr) * ldk + sc); vs1 = *(const GAS bf16x8*)(Vh + (size_t)((k0) + 32 + sr) * ldk + sc); \
    ks0 = *(const GAS bf16x8*)(Kh + (size_t)((k0) + sr) * ldk + sc); ks1 = *(const GAS bf16x8*)(Kh + (size_t)((k0) + 32 + sr) * ldk + sc); } while (0)
#define SWRITE(b) do { *(LAS bf16x8*)(V_lds + (b) * SHM_V + vst0) = vs0; *(LAS bf16x8*)(V_lds + (b) * SHM_V + vst1) = vs1; const int kc = sc * 2; \
    *(LAS bf16x8*)(K_lds + (b) * SHM_K + KSWZ(sr, kc)) = ks0; *(LAS bf16x8*)(K_lds + (b) * SHM_K + KSWZ(32 + sr, kc)) = ks1; } while (0)
    __syncthreads();
    SLOAD(0); SWRITE(0); if (nt > 1) SLOAD(KVBLK);
    __syncthreads();
    for (int j = 0; j < nt; ++j) {
        const int cur = j & 1;
        if (j + 1 < nt) { SWRITE(cur ^ 1); }
        if (j + 2 < nt) SLOAD((j + 2) * KVBLK);
        if (j < ntw) {
            u64 mw = 0; if (MASKED) mw = mrow[j];
            f32x16 p0, p1; bf16x8 pa0, pa1, pa2, pa3;
            qkt(p0, p1, K_lds + cur * SHM_K, qr, r32, hi);
            if (MASKED) { const unsigned lo = (unsigned)mw >> (4 * hi), hh = (unsigned)(mw >> 32) >> (4 * hi);
#pragma unroll
                for (int r = 0; r < 16; ++r) { const int bit = (r & 3) + 8 * (r >> 2); p0[r] = ((lo >> bit) & 1u) ? p0[r] : -INFINITY; p1[r] = ((hh >> bit) & 1u) ? p1[r] : -INFINITY; } }
            const float alpha = softmax_tile(p0, p1, m_reg, l_reg, pa0, pa1, pa2, pa3);
            if (__any(alpha < 1.f)) { if (hi == 0) wsf[r32] = alpha; asm volatile("s_waitcnt lgkmcnt(0)" ::: "memory");
#pragma unroll
                for (int d = 0; d < 4; ++d)
#pragma unroll
                    for (int r = 0; r < 16; ++r) o[d][r] *= wsf[crow(r, hi)]; }
            pv_d0(o, vb0 + cur * (int)SHM_V, pa0, pa1, pa2, pa3);
        }
        __syncthreads();
    }
    if (hi == 0) wsf[32 + r32] = l_reg; asm volatile("s_waitcnt lgkmcnt(0)" ::: "memory");
    if (ntw > 0) {
#pragma unroll
        for (int r = 0; r < 16; ++r) { const int orow = crow(r, hi); const float rl = __builtin_amdgcn_rcpf(wsf[32 + orow]);
#pragma unroll
            for (int d0 = 0; d0 < 4; ++d0) *(GAS bf16_t*)(orow0 + (size_t)orow * ldo + d0 * 32 + r32) = (bf16_t)f2bf(o[d0][r] * rl); }
    }
#undef SLOAD
#undef SWRITE
}
}
__device__ __forceinline__ void d3_unit(Frame& F, int b, int g, int i) {
    const int lane = F.lane, wave = F.wave, r32 = lane & 31, hi = lane >> 5;
    const int qblk = wave < 4 ? i : 127 - i, head = 4 * g + (wave & 3);
    const int ntw = (qblk >> 1) + 1, nt = ((127 - i) >> 1) + 1;
    const size_t row0 = (size_t)b * SEQ + qblk * 32;
    const bf16_t* qrow = (const bf16_t*)(F.ws + WS_DQ) + (row0 + r32) * 1024 + head * 128 + hi * 8;
    const bf16_t* Kh = (const bf16_t*)(F.ws + WS_DK) + (size_t)b * SEQ * 256 + g * 128; const bf16_t* Vh = (const bf16_t*)(F.ws + WS_DV) + (size_t)b * SEQ * 256 + g * 128;
    const u64* mrow = (const u64*)(F.ws + WS_MASK) + (row0 + r32) * 64;
    bf16_t* orow0 = (bf16_t*)(F.ws + WS_DSAO) + row0 * 1024 + head * 128;
    fa::attn_wg<true>(qrow, Kh, Vh, 256, nt, ntw, mrow, orow0, 1024, (LAS char*)F.lds, F.tid);
}
__device__ __forceinline__ void xattn_unit(Frame& F, int b, int h, int qb) {
    const int lane = F.lane, wave = F.wave, r32 = lane & 31, hi = lane >> 5;
    const size_t row0 = (size_t)b * SEQ + qb * 256 + wave * 32;
    const bf16_t* qrow = (const bf16_t*)(F.ws + WS_QM) + (row0 + r32) * 512 + h * 128 + hi * 8;
    const bf16_t* Kh = (const bf16_t*)(F.ws + WS_MEMKB) + (size_t)b * 256 * 512 + h * 128; const bf16_t* Vh = (const bf16_t*)(F.ws + WS_MEMVB) + (size_t)b * 256 * 512 + h * 128;
    bf16_t* orow0 = (bf16_t*)(F.ws + WS_OM) + row0 * 512 + h * 128;
    fa::attn_wg<false>(qrow, Kh, Vh, 512, 4, 4, nullptr, orow0, 512, (LAS char*)F.lds, F.tid);
}

__device__ __forceinline__ void r3_unit(Frame& F, const Args& A, int b, int n, int hp) {
    const int lane = F.lane, wave = F.wave, r32 = lane & 31, hi = lane >> 5, tb = wave & 3, hl = wave >> 2, head = 2 * hp + hl;
    LAS bf16_t* Vt = (LAS bf16_t*)F.lds + hl * (128 * TLD);
    const size_t row0 = (size_t)b * SEQ + n * 128;
    const bf16_t* RQ = (const bf16_t*)(F.ws + WS_RQ); const bf16_t* RK = (const bf16_t*)(F.ws + WS_RK); const bf16_t* RV = (const bf16_t*)(F.ws + WS_RV);
    __syncthreads();
    stage_tile128(RV + row0 * 1024 + (2 * hp) * 128, 1024, (LAS bf16_t*)F.lds, F.tid);
    stage_tile128(RV + row0 * 1024 + (2 * hp + 1) * 128, 1024, (LAS bf16_t*)F.lds + 128 * TLD, F.tid);
    bf16x8 qf[8];
#pragma unroll
    for (int ks = 0; ks < 8; ++ks) qf[ks] = *(const GAS bf16x8*)(RQ + (row0 + 32 * tb + r32) * 1024 + head * 128 + 16 * ks + 8 * hi);
    __syncthreads();
    f32x16 o[4] = {};
    for (int jb = 0; jb <= tb; ++jb) {
        f32x16 st = {};
#pragma unroll
        for (int ks = 0; ks < 8; ++ks) { const bf16x8 kf = *(const GAS bf16x8*)(RK + (row0 + 32 * jb + r32) * 1024 + head * 128 + 16 * ks + 8 * hi);
            st = __builtin_amdgcn_mfma_f32_32x32x16_bf16(kf, qf[ks], st, 0, 0, 0); }
        if (jb == tb) {
#pragma unroll
            for (int r = 0; r < 16; ++r) if (crow(r, hi) > r32) st[r] = 0.f;
        }
        bf16x8 pa0, pa1;
#define PK4(P, BASE, OUT) do { unsigned a0 = fa::cvtpk(P[BASE + 0], P[BASE + 1]), a1 = fa::cvtpk(P[BASE + 2], P[BASE + 3]);   \
    unsigned b0 = fa::cvtpk(P[BASE + 4], P[BASE + 5]), b1 = fa::cvtpk(P[BASE + 6], P[BASE + 7]);                              \
    auto r0 = __builtin_amdgcn_permlane32_swap(a0, b0, false, false); auto r1 = __builtin_amdgcn_permlane32_swap(a1, b1, false, false); \
    u32x4 w = {r0[0], r1[0], r0[1], r1[1]}; OUT = __builtin_bit_cast(bf16x8, w); } while (0)
        PK4(st, 0, pa0); PK4(st, 8, pa1);
#undef PK4
#pragma unroll
        for (int d = 0; d < 4; ++d) { const bf16x8 v0 = tr_frag(Vt, TLD, 32 * jb, 32 * d, lane), v1 = tr_frag(Vt, TLD, 32 * jb + 16, 32 * d, lane);
            o[d] = __builtin_amdgcn_mfma_f32_32x32x16_bf16(pa0, v0, o[d], 0, 0, 0); o[d] = __builtin_amdgcn_mfma_f32_32x32x16_bf16(pa1, v1, o[d], 0, 0, 0); }
    }
    {
        const bf16_t* SP = (const bf16_t*)(F.ws + WS_SPREV) + ((size_t)(b * 8 + head) * 32 + n) * 16384;
#pragma unroll
        for (int d = 0; d < 4; ++d)
#pragma unroll
            for (int ks = 0; ks < 8; ++ks) { const bf16x8 sf = *(const GAS bf16x8*)(SP + (32 * d + r32) * 128 + 16 * ks + 8 * hi);
                o[d] = __builtin_amdgcn_mfma_f32_32x32x16_bf16(qf[ks], sf, o[d], 0, 0, 0); }
    }
    const float* gn = (const float*)A.in[I_GNRET] + head * 128; const bf16_t* RG = (const bf16_t*)(F.ws + WS_RG); bf16_t* RY = (bf16_t*)(F.ws + WS_RETY);
    float gnv[4];
#pragma unroll
    for (int d = 0; d < 4; ++d) gnv[d] = gn[32 * d + r32];
#pragma unroll
    for (int r = 0; r < 16; ++r) {
        float s1 = (o[0][r] + o[1][r]) + (o[2][r] + o[3][r]);
#pragma unroll
        for (int x = 1; x < 32; x <<= 1) s1 += __shfl_xor(s1, x);
        const float mu = s1 * (1.0f / 128.0f);
        float s2 = 0.f;
#pragma unroll
        for (int d = 0; d < 4; ++d) { const float c = o[d][r] - mu; s2 += c * c; }
#pragma unroll
        for (int x = 1; x < 32; x <<= 1) s2 += __shfl_xor(s2, x);
        const float rs = 1.0f / sqrtf(s2 * (1.0f / 128.0f) + EPS);
        const size_t ro = (row0 + 32 * tb + crow(r, hi)) * 1024 + head * 128 + r32;
#pragma unroll
        for (int d = 0; d < 4; ++d) { const float sg = bf2f(*(const GAS bf16_t*)(RG + ro + 32 * d)); *(GAS bf16_t*)(RY + ro + 32 * d) = (bf16_t)f2bf((o[d][r] - mu) * rs * gnv[d] * sg); }
    }
}

__device__ __forceinline__ void s3_ret_unit(Frame& F, const Args& A, int bh) {
    const int tid = F.tid, b = bh >> 3, h = bh & 7, dv = tid & 127, sl = tid >> 7;
    LAS float* qs = (LAS float*)F.lds;
    LAS float* ks = qs + 512;
    LAS float* vs = ks + 512;
    LAS float* oc = vs + 512;
    LAS float* st = oc + 2048;
    LAS float* red = st + 16;
    const bf16_t* RQ = (const bf16_t*)(F.ws + WS_SMP + SM_RQ); const bf16_t* RK = (const bf16_t*)(F.ws + WS_SMP + SM_RK); const bf16_t* RV = (const bf16_t*)(F.ws + WS_SMP + SM_RV);
    __syncthreads();
    { const int t = tid >> 7, d = tid & 127; const size_t o = (size_t)(b * 4 + t) * 1024 + h * 128 + d; qs[tid] = bf2f(RQ[o]); ks[tid] = bf2f(RK[o]); vs[tid] = bf2f(RV[o]); }
    __syncthreads();
    if (tid < 16) { const int t = tid >> 2, j = tid & 3; float s = 0.f; for (int d = 0; d < 128; ++d) s += qs[t * 128 + d] * ks[j * 128 + d]; st[tid] = j <= t ? s : 0.f; }
    const float* S0 = (const float*)A.in[I_STATE] + (size_t)bh * 16384; float* SO = F.out + O_RSS + (size_t)bh * 16384;
    const float g4 = exp2f(4.0f * lg2g(h));
    const float v0 = vs[dv], v1 = vs[128 + dv], v2 = vs[256 + dv], v3 = vs[384 + dv];
    float c0 = 0.f, c1 = 0.f, c2 = 0.f, c3 = 0.f;
#pragma unroll 4
    for (int i = 0; i < 32; ++i) { const int dk = sl * 32 + i; const float s0 = S0[dk * 128 + dv];
        c0 += qs[dk] * s0; c1 += qs[128 + dk] * s0; c2 += qs[256 + dk] * s0; c3 += qs[384 + dk] * s0;
        SO[dk * 128 + dv] = g4 * (s0 + ks[dk] * v0 + ks[128 + dk] * v1 + ks[256 + dk] * v2 + ks[384 + dk] * v3); }
    oc[(sl * 4 + 0) * 128 + dv] = c0; oc[(sl * 4 + 1) * 128 + dv] = c1; oc[(sl * 4 + 2) * 128 + dv] = c2; oc[(sl * 4 + 3) * 128 + dv] = c3;
    __syncthreads();
    const int t = sl; float o = oc[(0 * 4 + t) * 128 + dv] + oc[(1 * 4 + t) * 128 + dv] + oc[(2 * 4 + t) * 128 + dv] + oc[(3 * 4 + t) * 128 + dv];
    o += st[t * 4 + 0] * v0 + st[t * 4 + 1] * v1 + st[t * 4 + 2] * v2 + st[t * 4 + 3] * v3;
    const float ws1 = wave_sum(o); if (F.lane == 0) red[t * 4 + (F.wave & 1)] = ws1;
    __syncthreads();
    const float mu = (red[t * 4 + 0] + red[t * 4 + 1]) * (1.0f / 128.0f); const float c = o - mu;
    const float ws2 = wave_sum(c * c); if (F.lane == 0) red[t * 4 + 2 + (F.wave & 1)] = ws2;
    __syncthreads();
    const float rs = 1.0f / sqrtf((red[t * 4 + 2] + red[t * 4 + 3]) * (1.0f / 128.0f) + EPS);
    const size_t ro = (size_t)(b * 4 + t) * 1024 + h * 128 + dv;
    const float sg = bf2f(((const bf16_t*)(F.ws + WS_SMP + SM_RG))[ro]);
    ((bf16_t*)(F.ws + WS_SMP + SM_RETY))[ro] = (bf16_t)f2bf(c * rs * ((const float*)A.in[I_GNRET])[h * 128 + dv] * sg);
}

template <typename T> __device__ __forceinline__ float ldv(const T* p);
template <> __device__ __forceinline__ float ldv<float>(const float* p) { return *(const GAS float*)p; }
template <> __device__ __forceinline__ float ldv<bf16_t>(const bf16_t* p) { return bf2f(*(const GAS bf16_t*)p); }
template <typename T, class KP, class VP>
__device__ __forceinline__ f32x2 wave_attn256(const LAS float* qv, LAS float* lg, KP kp, VP vp, int lane) {
    const int sub = lane & 15, kq = lane >> 4; float q8[8];
#pragma unroll
    for (int e = 0; e < 8; ++e) q8[e] = qv[8 * sub + e];
    for (int it = 0; it < 64; ++it) { const int key = 4 * it + kq; const T* k = kp(key) + 8 * sub; float d = 0.f;
#pragma unroll
        for (int e = 0; e < 8; ++e) d += q8[e] * ldv<T>(k + e);
        d = sum16(d); if (sub == 0) lg[key] = d; }
    LDS_WAIT();
    float l0 = lg[lane], l1 = lg[64 + lane], l2 = lg[128 + lane], l3 = lg[192 + lane];
    const float mx = wave_max(fmaxf(fmaxf(l0, l1), fmaxf(l2, l3)));
    l0 = __expf(l0 - mx); l1 = __expf(l1 - mx); l2 = __expf(l2 - mx); l3 = __expf(l3 - mx);
    const float inv = 1.0f / wave_sum((l0 + l1) + (l2 + l3));
    lg[lane] = l0 * inv; lg[64 + lane] = l1 * inv; lg[128 + lane] = l2 * inv; lg[192 + lane] = l3 * inv;
    LDS_WAIT();
    float a0 = 0.f, a1 = 0.f;
#pragma unroll 4
    for (int key = 0; key < 256; ++key) { const float p = lg[key]; const T* v = vp(key) + 2 * lane; a0 += p * ldv<T>(v); a1 += p * ldv<T>(v + 1); }
    return (f32x2){a0, a1};
}
__device__ __forceinline__ void s3_attn_unit(Frame& F, const Args& A, int q) {
    const int lane = F.lane, wave = F.wave, tid = F.tid, b = q >> 2, g = wave >> 2;
    LAS int* koff = (LAS int*)F.lds;
    LAS float* qv = (LAS float*)(F.lds + 1024) + wave * 128; LAS float* lg = (LAS float*)(F.lds + 1024 + 4096) + wave * 256;
    const int* sidx = (const int*)(F.ws + WS_SMP + SM_SIDX) + q * 256; const int* PT = (const int*)A.in[I_PT];
    __syncthreads();
    if (tid < 256) { const int s = sidx[tid]; int v; if (s < PAST) v = (PT[b * 128 + (s >> 7)] * 128 + (s & 127)); else v = -(1 + (b * 4 + (s - PAST))); koff[tid] = v; }
    { const bf16_t* dq = (const bf16_t*)(F.ws + WS_SMP + SM_DQ) + (size_t)q * 1024 + wave * 128; qv[lane] = bf2f(dq[lane]) * QK_SCALE; qv[64 + lane] = bf2f(dq[64 + lane]) * QK_SCALE; }
    __syncthreads();
    const float* CK = (const float*)A.in[I_CK]; const float* CV = (const float*)A.in[I_CV]; const float* NK = F.out + O_KS; const float* NV = F.out + O_VS;
    auto kp = [&](int key) -> const float* { const int v = koff[key]; return v >= 0 ? CK + (size_t)v * 256 + g * 128 : NK + (size_t)(-1 - v) * 256 + g * 128; };
    auto vp = [&](int key) -> const float* { const int v = koff[key]; return v >= 0 ? CV + (size_t)v * 256 + g * 128 : NV + (size_t)(-1 - v) * 256 + g * 128; };
    const f32x2 o = wave_attn256<float>(qv, lg, kp, vp, lane);
    *(GAS unsigned*)((bf16_t*)(F.ws + WS_SMP + SM_DSAO) + (size_t)q * 1024 + wave * 128 + 2 * lane) = pk2(o.x, o.y);
}
__device__ __forceinline__ void s7_xattn_unit(Frame& F, int b) {
    const int lane = F.lane, wave = F.wave;
    LAS float* qv = (LAS float*)(F.lds) + wave * 128; LAS float* lg = (LAS float*)(F.lds + 4096) + wave * 256;
    const bf16_t* MK = (const bf16_t*)(F.ws + WS_MEMKB) + (size_t)(2 + b) * 256 * 512; const bf16_t* MV = (const bf16_t*)(F.ws + WS_MEMVB) + (size_t)(2 + b) * 256 * 512;
    __syncthreads();
    for (int c = 0; c < 2; ++c) { const int th = wave * 2 + c, t = th >> 2, h = th & 3, q = b * 4 + t;
        const bf16_t* qm = (const bf16_t*)(F.ws + WS_SMP + SM_QM) + (size_t)q * 512 + h * 128;
        LDS_WAIT(); qv[lane] = bf2f(qm[lane]) * QK_SCALE; qv[64 + lane] = bf2f(qm[64 + lane]) * QK_SCALE; LDS_WAIT();
        auto kp = [&](int key) -> const bf16_t* { return MK + (size_t)key * 512 + h * 128; };
        auto vp = [&](int key) -> const bf16_t* { return MV + (size_t)key * 512 + h * 128; };
        const f32x2 o = wave_attn256<bf16_t>(qv, lg, kp, vp, lane);
        *(GAS unsigned*)((bf16_t*)(F.ws + WS_SMP + SM_OM) + (size_t)q * 512 + h * 128 + 2 * lane) = pk2(o.x, o.y); }
}
__device__ __forceinline__ f32x4 ld_bf4(const bf16_t* p) { const u32x2 w = *(const GAS u32x2*)p; return (f32x4){bflo(w.x), bfhi(w.x), bflo(w.y), bfhi(w.y)}; }
__device__ __forceinline__ float rowsq64(const f32x4& a, const f32x4& b, const f32x4& c, const f32x4& d) {
    float s = (a.x * a.x + a.y * a.y) + (a.z * a.z + a.w * a.w) + (b.x * b.x + b.y * b.y) + (b.z * b.z + b.w * b.w)
            + (c.x * c.x + c.y * c.y) + (c.z * c.z + c.w * c.w) + (d.x * d.x + d.y * d.y) + (d.z * d.z + d.w * d.w);
    s += __shfl_xor(s, 16); s += __shfl_xor(s, 32); return s;
}
__device__ __forceinline__ float rstd32(const float* ssq, int row) {
    const GAS f32x4* p = (const GAS f32x4*)(ssq + (size_t)row * 32); float s = 0.f;
#pragma unroll
    for (int i = 0; i < 8; ++i) { const f32x4 v = p[i]; s += (v.x + v.y) + (v.z + v.w); }
    return 1.0f / sqrtf(s * (1.0f / DM) + EPS);
}
struct EpiMerge {
    static constexpr bool PERM = false, AFTER_DRAIN = false;
    const bf16_t* GA; const bf16_t* GB; float* T1; bf16_t* MG;
    __device__ __forceinline__ void operator()(const f32x4 (&acc)[2][2][4][2], const pg8::Unit& u, int wr, int wc, int fr, int fq) const {
        const bool second = u.pm >= 32; const int pm = second ? u.pm - 32 : u.pm, pn = second ? u.pn - 8 : u.pn;
        const int rowb = pm * 256 + wr * 64 + fr, cb = pn * 256 + 32 * wc + 4 * fq;
#pragma unroll
        for (int ai = 0; ai < 2; ++ai)
#pragma unroll
            for (int m = 0; m < 4; ++m) { const size_t ro = (size_t)(rowb + ai * 128 + m * 16) * DM + cb;
#pragma unroll
                for (int bj = 0; bj < 2; ++bj)
#pragma unroll
                    for (int n = 0; n < 2; ++n) { const size_t off = ro + bj * 128 + 16 * n;
                        if (!second) *(GAS f32x4*)(T1 + off) = ld_bf4(GA + off) * acc[ai][bj][m][n];
                        else st_bf4(MG + off, *(const GAS f32x4*)(T1 + off) + ld_bf4(GB + off) * acc[ai][bj][m][n]); } }
    }
};
struct EpiResid {
    static constexpr bool PERM = false, AFTER_DRAIN = false;
    const float* R; float* H; bf16_t* HB; float* SSQ;
    __device__ __forceinline__ void operator()(const f32x4 (&acc)[2][2][4][2], const pg8::Unit& u, int wr, int wc, int fr, int fq) const {
        const int rowb = u.pm * 256 + wr * 64 + fr, cb = u.pn * 256 + 32 * wc + 4 * fq;
#pragma unroll
        for (int ai = 0; ai < 2; ++ai)
#pragma unroll
            for (int m = 0; m < 4; ++m) { const int row = rowb + ai * 128 + m * 16; const size_t ro = (size_t)row * DM + cb; f32x4 v[2][2];
#pragma unroll
                for (int bj = 0; bj < 2; ++bj)
#pragma unroll
                    for (int n = 0; n < 2; ++n) { const size_t off = ro + bj * 128 + 16 * n; v[bj][n] = *(const GAS f32x4*)(R + off) + acc[ai][bj][m][n];
                        *(GAS f32x4*)(H + off) = v[bj][n]; if (HB) st_bf4(HB + off, v[bj][n]); }
                const float s = rowsq64(v[0][0], v[0][1], v[1][0], v[1][1]);
                if (fq == 0) SSQ[(size_t)row * 32 + u.pn * 4 + wc] = s; }
    }
};
struct EpiQm {
    static constexpr bool PERM = false, AFTER_DRAIN = false;
    const float* SSQ; bf16_t* QM;
    __device__ __forceinline__ void operator()(const f32x4 (&acc)[2][2][4][2], const pg8::Unit& u, int wr, int wc, int fr, int fq) const {
        const int rowb = u.pm * 256 + wr * 64 + fr, cb = u.pn * 256 + 32 * wc + 4 * fq;
#pragma unroll
        for (int ai = 0; ai < 2; ++ai)
#pragma unroll
            for (int m = 0; m < 4; ++m) { const int row = rowb + ai * 128 + m * 16; const float rs = rstd32(SSQ, row);
#pragma unroll
                for (int bj = 0; bj < 2; ++bj)
#pragma unroll
                    for (int n = 0; n < 2; ++n) st_bf4(QM + (size_t)row * MEMW + cb + bj * 128 + 16 * n, acc[ai][bj][m][n] * rs); }
    }
};
struct EpiUp {
    static constexpr bool PERM = false, AFTER_DRAIN = false;
    const float* SSQ; bf16_t* ACT;
    __device__ __forceinline__ void operator()(const f32x4 (&acc)[2][2][4][2], const pg8::Unit& u, int wr, int wc, int fr, int fq) const {
        const int rowb = u.pm * 256 + wr * 64 + fr, cb = u.pn * 256 + 32 * wc + 4 * fq;
#pragma unroll
        for (int ai = 0; ai < 2; ++ai)
#pragma unroll
            for (int m = 0; m < 4; ++m) { const int row = rowb + ai * 128 + m * 16; const float rs = rstd32(SSQ, row);
#pragma unroll
                for (int bj = 0; bj < 2; ++bj)
#pragma unroll
                    for (int n = 0; n < 2; ++n) { f32x4 v = acc[ai][bj][m][n] * rs; v.x = fmaxf(v.x, 0.f); v.y = fmaxf(v.y, 0.f); v.z = fmaxf(v.z, 0.f); v.w = fmaxf(v.w, 0.f);
                        st_bf4(ACT + (size_t)row * DFF + cb + bj * 128 + 16 * n, v * v); } }
    }
};
__device__ __forceinline__ void final_norm_row(float* y, const float* ssq, int np, const float* g, int lane) {
    float s = 0.f; for (int i = lane; i < np; i += 64) s += ssq[i]; s = wave_sum(s);
    const float rs = 1.0f / sqrtf(s * (1.0f / DM) + EPS);
    GAS f32x4* yr = (GAS f32x4*)y + lane; const GAS f32x4* gr = (const GAS f32x4*)g + lane;
#pragma unroll
    for (int j = 0; j < 8; ++j) { const f32x4 v = yr[64 * j], gg = gr[64 * j]; yr[64 * j] = v * rs * gg; }
}
__device__ __forceinline__ float rstd_n(const float* ssq, int n) { float s = 0.f; for (int i = 0; i < n; ++i) s += ssq[i]; return 1.0f / sqrtf(s * (1.0f / DM) + EPS); }
constexpr int N_PHASES = 13;
__global__ void __launch_bounds__(NWAVES * 64, 2) mega_fwd(Args args) {
    extern __shared__ __attribute__((aligned(16))) unsigned char lds_raw[];
    Frame F;
    F.lds = (LAS unsigned char*)lds_raw; F.ws = args.ws; F.out = args.out;
    F.tid = threadIdx.x; F.lane = F.tid & 63; F.wave = __builtin_amdgcn_readfirstlane(F.tid >> 6);
    F.G = gridDim.x; { const int bx = blockIdx.x; F.vcu = (F.G % 8 == 0) ? (bx % 8) * (F.G / 8) + bx / 8 : bx; }
    volatile LAS unsigned* MISC = (volatile LAS unsigned*)(F.lds + MISC_OFF);
    for (int u = F.tid; u < (LDS_BYTES - LDSCTL_OFF) / 4; u += NWAVES * 64) ((LAS unsigned*)(F.lds + LDSCTL_OFF))[u] = 0u;
    __syncthreads();
    unsigned char* ws = args.ws;
    const bool multi = (args.ph_hi - args.ph_lo) > 1;
    XcdBarrier bar; bar.bar = (unsigned*)(ws + WS_CTL) + CW_BAR; bar.x = 0; bar.st = nullptr;
    if (multi) bar = xcd_barrier_post((unsigned*)(ws + WS_CTL) + CW_BAR, MISC + 8);
    const int lo = args.ph_lo, hi = args.ph_hi, G = F.G, cid = (int)blockIdx.x;
    LAS unsigned char* lds = F.lds; LAS float* red = (LAS float*)lds;
#ifndef PH_MASK
#define PH_MASK 0xFFFF
#endif
#define PHASE_ON(k) ((PH_MASK >> (k)) & 1)
#ifndef REP_MASK
#define REP_MASK 0
#endif
#define NREP(k) (1 + ((REP_MASK >> (k)) & 1))
#ifndef SUBREP_MASK
#define SUBREP_MASK 0
#endif
#define SUBREP(k) (1 + ((SUBREP_MASK >> (k)) & 1))
#define IN(k) (lo <= (k) && (k) < hi)
#define SEAM(k) do { if (IN(k) && IN((k) + 1)) xcd_barrier(bar); } while (0)
    float* out = args.out;
    unsigned char* sm = ws + WS_SMP;

    for (int rep_ = 0; rep_ < NREP(0) && PHASE_ON(0) && IN(0); ++rep_) { if (rep_) xcd_barrier(bar); p0_prologue(F, args); }
    SEAM(0);
    for (int rep_ = 0; rep_ < NREP(1) && PHASE_ON(1) && IN(1); ++rep_) { if (rep_) xcd_barrier(bar);
        {
            pg8::Gemm g{(const bf16_t*)(ws + WS_XN), (const bf16_t*)(ws + WS_WT1), MP, NV1, DM};
            OrderX S; S.initx(MP, NV1, G, cid, 8, 32, 43, 4);
            EpiIn E{ws, out};
            pg8::gemm_phase<EpiIn, OrderX, true, true>(lds, g, S, E);
        }
        for (int nb = cid; nb < NV1 / 32; nb += G) {
            const f32x16 acc = skinny_partial((const bf16_t*)(sm + SM_XN), DM, (const bf16_t*)(ws + WS_WT1), DM, nb, F.wave, F.lane);
            float v1, v2; skinny_reduce(acc, red, F.wave, F.lane, F.tid, v1, v2);
            epi_in_sample(ws, out, F.tid >> 4, nb, F.tid & 15, v1, v2);
        }
    }
    SEAM(1);
    for (int rep_ = 0; rep_ < NREP(2) && PHASE_ON(2) && IN(2); ++rep_) { if (rep_) xcd_barrier(bar);
        for (int u = F.vcu; u < 1056 + 512 + 256 + 8; u += G) {
            if (u < 1056) { const int b = u / 528, x = u % 528; int qb = (int)((sqrtf(8.0f * x + 1.0f) - 1.0f) * 0.5f); while ((qb + 1) * (qb + 2) / 2 <= x) ++qb; while (qb * (qb + 1) / 2 > x) --qb;
                d1_unit(F, b, qb, x - qb * (qb + 1) / 2); }
            else if (u < 1568) { const int x = u - 1056; r1_unit(F, x >> 5, x & 31); }
            else if (u < 1824) { const int x = u - 1568; s1_unit(F, args, x >> 5, x & 31); }
            else { if (F.wave == 0) s1_tail(F, u - 1824); }
        }
    }
    SEAM(2);
    for (int rep_ = 0; rep_ < NREP(3) && PHASE_ON(3) && IN(3); ++rep_) { if (rep_) xcd_barrier(bar);
        for (int sr_ = 0; sr_ < SUBREP(0); ++sr_) if (F.vcu < MS) s2_row(F, F.vcu);
        for (int sr_ = 0; sr_ < SUBREP(1); ++sr_) r2_scan(F);
        for (int sr_ = 0; sr_ < SUBREP(2); ++sr_) for (int row = F.vcu * NWAVES + F.wave; row < MP; row += G * NWAVES) d2_row(F, row);
    }
    SEAM(3);
    for (int rep_ = 0; rep_ < NREP(4) && PHASE_ON(4) && IN(4); ++rep_) { if (rep_) xcd_barrier(bar);
        for (int sr_ = 0; sr_ < SUBREP(3); ++sr_) for (int u = F.vcu; u < 256; u += G) d3_unit(F, u >> 7, (u >> 6) & 1, u & 63);
        for (int sr_ = 0; sr_ < SUBREP(4); ++sr_) for (int u = F.vcu; u < 256; u += G) r3_unit(F, args, u >> 7, (u >> 2) & 31, u & 3);
        for (int sr_ = 0; sr_ < SUBREP(5); ++sr_) for (int u = F.vcu; u < 96; u += G) { if (u < 32) s3_attn_unit(F, args, u); else s3_ret_unit(F, args, u - 32); }
    }
    SEAM(4);
    for (int rep_ = 0; rep_ < NREP(5) && PHASE_ON(5) && IN(5); ++rep_) { if (rep_) xcd_barrier(bar);
        {
            pg8::Gemm g{(const bf16_t*)(ws + WS_RETY), (const bf16_t*)(ws + WS_WRO), MP, DM, 1024};
            OrderDual S; S.init(MP, DM, G, cid);
            EpiMerge E{(const bf16_t*)(ws + WS_GA), (const bf16_t*)(ws + WS_GB), (float*)(ws + WS_T1), (bf16_t*)(ws + WS_MERGED)};
            pg8::gemm_phase<EpiMerge, OrderDual, false, true>(lds, g, S, E);
        }
        for (int nb = cid; nb < DM / 32; nb += G) {
            const f32x16 a1 = skinny_partial((const bf16_t*)(sm + SM_RETY), 1024, (const bf16_t*)(ws + WS_WRO), 1024, nb, F.wave, F.lane);
            const f32x16 a2 = skinny_partial((const bf16_t*)(sm + SM_DSAO), 1024, (const bf16_t*)(ws + WS_WDO), 1024, nb, F.wave, F.lane);
            float y1, y2, z1, z2; skinny_reduce(a1, red, F.wave, F.lane, F.tid, y1, y2); skinny_reduce(a2, red, F.wave, F.lane, F.tid, z1, z2);
            const int row = F.tid >> 4, col = nb * 32 + (F.tid & 15); const size_t o = (size_t)row * DM + col;
            const bf16_t* ga = (const bf16_t*)(sm + SM_GA); const bf16_t* gb = (const bf16_t*)(sm + SM_GB); bf16_t* mg = (bf16_t*)(sm + SM_MERGED);
            st1(mg + o, bf2f(ga[o]) * y1 + bf2f(gb[o]) * z1); st1(mg + o + 16, bf2f(ga[o + 16]) * y2 + bf2f(gb[o + 16]) * z2);
        }
    }
    SEAM(5);
    for (int rep_ = 0; rep_ < NREP(6) && PHASE_ON(6) && IN(6); ++rep_) { if (rep_) xcd_barrier(bar);
        {
            pg8::Gemm g{(const bf16_t*)(ws + WS_MERGED), (const bf16_t*)(ws + WS_WO), MP, DM, DM};
            pg8::StaticOrder S; S.init(MP, DM, G, cid);
            EpiResid E{(const float*)args.in[I_XP], (float*)(ws + WS_H1), (bf16_t*)(ws + WS_H1B), (float*)(ws + WS_SSQ)};
            pg8::gemm_phase<EpiResid, pg8::StaticOrder, false, true>(lds, g, S, E);
        }
        for (int nb = cid; nb < DM / 32; nb += G) {
            const f32x16 a1 = skinny_partial((const bf16_t*)(sm + SM_MERGED), DM, (const bf16_t*)(ws + WS_WO), DM, nb, F.wave, F.lane);
            float y1, y2; skinny_reduce(a1, red, F.wave, F.lane, F.tid, y1, y2);
            const int row = F.tid >> 4, col = nb * 32 + (F.tid & 15); const size_t o = (size_t)row * DM + col; const float* xs = (const float*)args.in[I_XS];
            y1 += xs[o]; y2 += xs[o + 16]; ((float*)(sm + SM_H1))[o] = y1; ((float*)(sm + SM_H1))[o + 16] = y2; st1((bf16_t*)(sm + SM_H1B) + o, y1); st1((bf16_t*)(sm + SM_H1B) + o + 16, y2);
            const float s = sum16(y1 * y1 + y2 * y2); if ((F.tid & 15) == 0) ((float*)(sm + SM_SSQ))[row * 64 + nb] = s;
        }
    }
    SEAM(6);
    for (int rep_ = 0; rep_ < NREP(7) && PHASE_ON(7) && IN(7); ++rep_) { if (rep_) xcd_barrier(bar);
        {
            pg8::Gemm g{(const bf16_t*)(ws + WS_H1B), (const bf16_t*)(ws + WS_WMQ), MP, MEMW, DM};
            pg8::StaticOrder S; S.init(MP, MEMW, G, cid);
            EpiQm E{(const float*)(ws + WS_SSQ), (bf16_t*)(ws + WS_QM)};
            pg8::gemm_phase<EpiQm, pg8::StaticOrder, false, true>(lds, g, S, E);
        }
        for (int nb = cid; nb < MEMW / 32; nb += G) {
            const f32x16 a1 = skinny_partial((const bf16_t*)(sm + SM_H1B), DM, (const bf16_t*)(ws + WS_WMQ), DM, nb, F.wave, F.lane);
            float y1, y2; skinny_reduce(a1, red, F.wave, F.lane, F.tid, y1, y2);
            const int row = F.tid >> 4, col = nb * 32 + (F.tid & 15); const float rs = rstd_n((const float*)(sm + SM_SSQ) + row * 64, 64);
            st1((bf16_t*)(sm + SM_QM) + row * MEMW + col, y1 * rs); st1((bf16_t*)(sm + SM_QM) + row * MEMW + col + 16, y2 * rs);
        }
    }
    SEAM(7);
    for (int rep_ = 0; rep_ < NREP(8) && PHASE_ON(8) && IN(8); ++rep_) { if (rep_) xcd_barrier(bar);
        for (int u = F.vcu; u < 136; u += G) { if (u < 128) xattn_unit(F, u >> 6, (u >> 4) & 3, u & 15); else s7_xattn_unit(F, u - 128); }
    }
    SEAM(8);
    for (int rep_ = 0; rep_ < NREP(9) && PHASE_ON(9) && IN(9); ++rep_) { if (rep_) xcd_barrier(bar);
        {
            pg8::Gemm g{(const bf16_t*)(ws + WS_OM), (const bf16_t*)(ws + WS_WMO), MP, DM, MEMW};
            pg8::StaticOrder S; S.init(MP, DM, G, cid);
            EpiResid E{(const float*)(ws + WS_H1), (float*)(ws + WS_H1), (bf16_t*)(ws + WS_H1B), (float*)(ws + WS_SSQ + 1 * MiB)};
            pg8::gemm_phase<EpiResid, pg8::StaticOrder, false, true>(lds, g, S, E);
        }
        for (int nb = cid; nb < DM / 32; nb += G) {
            const f32x16 a1 = skinny_partial((const bf16_t*)(sm + SM_OM), MEMW, (const bf16_t*)(ws + WS_WMO), MEMW, nb, F.wave, F.lane);
            float y1, y2; skinny_reduce(a1, red, F.wave, F.lane, F.tid, y1, y2);
            const int row = F.tid >> 4, col = nb * 32 + (F.tid & 15); const size_t o = (size_t)row * DM + col; float* h = (float*)(sm + SM_H1);
            y1 += h[o]; y2 += h[o + 16]; h[o] = y1; h[o + 16] = y2; st1((bf16_t*)(sm + SM_H1B) + o, y1); st1((bf16_t*)(sm + SM_H1B) + o + 16, y2);
            const float s = sum16(y1 * y1 + y2 * y2); if ((F.tid & 15) == 0) ((float*)(sm + SM_SSQ))[2048 + row * 64 + nb] = s;
        }
    }
    SEAM(9);
    for (int rep_ = 0; rep_ < NREP(10) && PHASE_ON(10) && IN(10); ++rep_) { if (rep_) xcd_barrier(bar);
        {
            pg8::Gemm g{(const bf16_t*)(ws + WS_H1B), (const bf16_t*)(ws + WS_WUP), MP, DFF, DM};
            pg8::StaticOrder S; S.init(MP, DFF, G, cid);
            EpiUp E{(const float*)(ws + WS_SSQ + 1 * MiB), (bf16_t*)(ws + WS_ACT)};
            pg8::gemm_phase<EpiUp, pg8::StaticOrder, true, true>(lds, g, S, E);
        }
        for (int nb = cid; nb < DFF / 32; nb += G) {
            const f32x16 a1 = skinny_partial((const bf16_t*)(sm + SM_H1B), DM, (const bf16_t*)(ws + WS_WUP), DM, nb, F.wave, F.lane);
            float y1, y2; skinny_reduce(a1, red, F.wave, F.lane, F.tid, y1, y2);
            const int row = F.tid >> 4, col = nb * 32 + (F.tid & 15); const float rs = rstd_n((const float*)(sm + SM_SSQ) + 2048 + row * 64, 64);
            y1 = fmaxf(y1 * rs, 0.f); y2 = fmaxf(y2 * rs, 0.f);
            st1((bf16_t*)(sm + SM_ACT) + (size_t)row * DFF + col, y1 * y1); st1((bf16_t*)(sm + SM_ACT) + (size_t)row * DFF + col + 16, y2 * y2);
        }
    }
    SEAM(10);
    for (int rep_ = 0; rep_ < NREP(11) && PHASE_ON(11) && IN(11); ++rep_) { if (rep_) xcd_barrier(bar);
        {
            pg8::Gemm g{(const bf16_t*)(ws + WS_ACT), (const bf16_t*)(ws + WS_WDN), MP, DM, DFF};
            pg8::StaticOrder S; S.init(MP, DM, G, cid);
            EpiResid E{(const float*)(ws + WS_H1), out + O_Y, nullptr, (float*)(ws + WS_SSQ + 2 * MiB)};
            pg8::gemm_phase<EpiResid, pg8::StaticOrder, false, true>(lds, g, S, E);
        }
        for (int nb = cid; nb < DM / 32; nb += G) {
            const f32x16 a1 = skinny_partial((const bf16_t*)(sm + SM_ACT), DFF, (const bf16_t*)(ws + WS_WDN), DFF, nb, F.wave, F.lane);
            float y1, y2; skinny_reduce(a1, red, F.wave, F.lane, F.tid, y1, y2);
            const int row = F.tid >> 4, col = nb * 32 + (F.tid & 15); const size_t o = (size_t)row * DM + col; const float* h = (const float*)(sm + SM_H1);
            y1 += h[o]; y2 += h[o + 16]; out[O_YS + o] = y1; out[O_YS + o + 16] = y2;
            const float s = sum16(y1 * y1 + y2 * y2); if ((F.tid & 15) == 0) ((float*)(sm + SM_SSQ))[4096 + row * 64 + nb] = s;
        }
    }
    SEAM(11);
    for (int rep_ = 0; rep_ < NREP(12) && PHASE_ON(12) && IN(12); ++rep_) { if (rep_) xcd_barrier(bar);
        const float* gf = (const float*)args.in[I_GFINAL];
        for (int row = F.vcu * NWAVES + F.wave; row < MP + MS; row += G * NWAVES) {
            if (row < MP) final_norm_row(out + O_Y + (size_t)row * DM, (const float*)(ws + WS_SSQ + 2 * MiB) + (size_t)row * 32, 32, gf, F.lane);
            else final_norm_row(out + O_YS + (size_t)(row - MP) * DM, (const float*)(sm + SM_SSQ) + 4096 + (row - MP) * 64, 64, gf, F.lane);
        }
    }
#undef IN
#undef SEAM
}

#ifndef HOST_REP_MASK
#define HOST_REP_MASK 0
#endif
#ifndef MK_N_LAUNCHES
#define MK_N_LAUNCHES 1
#endif
extern "C" void kernel_launch(void* const* d_in, const int* in_sizes, int n_in, void* d_out, int out_size, void* d_ws, size_t ws_size, hipStream_t stream) {
    static int grid = 0;
    if (grid == 0) {
        if (n_in != 26 || ws_size < WS_END) { fprintf(stderr, "kernel_launch: expected 26 inputs and >= %zu bytes of workspace; got %d inputs, %zu bytes\n", (size_t)WS_END, n_in, ws_size); grid = -1; return; }
        int dev = 0, cus = 0, per_cu = 0;
        if (hipGetDevice(&dev) != hipSuccess || hipDeviceGetAttribute(&cus, hipDeviceAttributeMultiprocessorCount, dev) != hipSuccess) { grid = -1; return; }
        if (hipFuncSetAttribute((const void*)mega_fwd, hipFuncAttributeMaxDynamicSharedMemorySize, LDS_BYTES) != hipSuccess) { fprintf(stderr, "kernel_launch: hipFuncSetAttribute failed\n"); grid = -1; return; }
        if (hipOccupancyMaxActiveBlocksPerMultiprocessor(&per_cu, (const void*)mega_fwd, NWAVES * 64, LDS_BYTES) != hipSuccess || per_cu < 1)
            fprintf(stderr, "kernel_launch: occupancy query reports %d workgroups per CU\n", per_cu);
        (void)hipGetLastError();
        grid = cus;
    }
    if (grid < 0) return;
    if (hipMemsetAsync((char*)d_ws + WS_CTL, 0, CTL_ZERO_BYTES, stream) != hipSuccess) return;
    Args a{};
    for (int i = 0; i < 26; ++i) a.in[i] = d_in[i];
    a.out = (float*)d_out; a.ws = (unsigned char*)d_ws;
    if (MK_N_LAUNCHES == 1) { a.ph_lo = 0; a.ph_hi = N_PHASES; hipLaunchKernelGGL(mega_fwd, dim3(grid), dim3(NWAVES * 64), LDS_BYTES, stream, a); }
    else for (int p = 0; p < N_PHASES; ++p) { a.ph_lo = p; a.ph_hi = p + 1; for (int r = 0; r < 1 + ((HOST_REP_MASK >> p) & 1); ++r) hipLaunchKernelGGL(mega_fwd, dim3(grid), dim3(NWAVES * 64), LDS_BYTES, stream, a); }
    const hipError_t le = hipPeekAtLastError();
    if (le != hipSuccess) fprintf(stderr, "kernel_launch: launch failed: %s\n", hipGetErrorName(le));
}
```

```cpp
#include <hip/hip_runtime.h>
#include <cstdio>
#include <cstdint>

#define LAS __attribute__((address_space(3)))
#define GAS __attribute__((address_space(1)))
typedef unsigned short bf16_t;
typedef short bf16x8 __attribute__((ext_vector_type(8)));
typedef short s16x4 __attribute__((ext_vector_type(4)));
typedef float f32x2 __attribute__((ext_vector_type(2)));
typedef float f32x4 __attribute__((ext_vector_type(4)));
typedef float f32x16 __attribute__((ext_vector_type(16)));
typedef unsigned u32x2 __attribute__((ext_vector_type(2)));
typedef unsigned u32x4 __attribute__((ext_vector_type(4)));
typedef unsigned long long u64;

constexpr int DM = 2048, SEQ = 4096, MP = 8192, MS = 32, NIN = 10832, NV1 = 11008, DFF = 8192, MEMW = 512;
constexpr int PAST = 16384, NTPOS = 4100;
constexpr int SLEN = 16400;
constexpr float EPS = 1e-6f;
constexpr float QK_SCALE = 0.08838834764831845f;

constexpr size_t O_Y = 0, O_YS = 16777216, O_RSP = 16842752, O_KP = 17104896, O_VP = 19202048, O_IKP = 21299200, O_MK = 21823488, O_MV = 22085632,
                 O_RSS = 22347776, O_KS = 23396352, O_VS = 23404544, O_IKS = 23412736;

constexpr size_t MiB = 1u << 20, KiB = 1u << 10;
constexpr size_t WS_CTL = 0, CTL_ZERO_BYTES = 1 * MiB;
constexpr size_t WS_TAB = 1 * MiB;
constexpr size_t TAB_COS64 = 0, TAB_SIN64 = (size_t)NTPOS * 64 * 4, TAB_COS16 = 2 * TAB_SIN64, TAB_SIN16 = TAB_COS16 + (size_t)NTPOS * 16 * 4,
                 TAB_COS8 = TAB_SIN16 + (size_t)NTPOS * 16 * 4, TAB_SIN8 = TAB_COS8 + (size_t)NTPOS * 8 * 4;
static_assert(TAB_SIN8 + (size_t)NTPOS * 8 * 4 <= 3 * MiB, "tables");
constexpr size_t WS_SSQ = 4 * MiB;
constexpr size_t WS_WT1 = 8 * MiB;
constexpr size_t WS_WRO = 55 * MiB, WS_WDO = 59 * MiB, WS_WO = 63 * MiB, WS_WMQ = 71 * MiB, WS_WMO = 73 * MiB, WS_WUP = 75 * MiB, WS_WDN = 107 * MiB;
constexpr size_t WS_XN = 139 * MiB;
constexpr size_t WS_RQ = 173 * MiB, WS_RK = 189 * MiB, WS_RV = 205 * MiB, WS_RG = 221 * MiB;
constexpr size_t WS_DQ = 237 * MiB, WS_DK = 253 * MiB, WS_DV = 257 * MiB, WS_IQ = 261 * MiB, WS_IK = 277 * MiB, WS_IW = 278 * MiB;
constexpr size_t WS_GA = 279 * MiB, WS_GB = 311 * MiB;
constexpr size_t WS_SCORES = 343 * MiB;
constexpr size_t WS_KVC = 471 * MiB;
constexpr size_t WS_SPREV = 503 * MiB;
constexpr size_t WS_MASK = 519 * MiB;
constexpr size_t WS_RETY = 523 * MiB, WS_DSAO = 539 * MiB;
constexpr size_t WS_MERGED = 555 * MiB, WS_H1B = 587 * MiB, WS_QM = 619 * MiB, WS_OM = 627 * MiB, WS_MEMKB = 635 * MiB, WS_MEMVB = 638 * MiB;
constexpr size_t WS_SMP = 641 * MiB;
constexpr size_t WS_END = 665 * MiB;
constexpr size_t WS_QMP = WS_SCORES;
constexpr size_t WS_H1 = WS_RQ;
constexpr size_t WS_ACT = WS_SCORES;
constexpr size_t SM_XN = 0, SM_RQ = 512 * KiB, SM_RK = 1024 * KiB, SM_RV = 1536 * KiB, SM_RG = 2048 * KiB, SM_DQ = 2560 * KiB, SM_DK = 3072 * KiB, SM_DV = 3584 * KiB,
                 SM_IQ = 4096 * KiB, SM_IK = 4608 * KiB, SM_IW = 5120 * KiB, SM_GA = 5632 * KiB, SM_GB = 6144 * KiB, SM_RETY = 6656 * KiB, SM_DSAO = 7168 * KiB,
                 SM_MERGED = 7680 * KiB, SM_H1 = 8192 * KiB, SM_H1B = 8704 * KiB, SM_QM = 9216 * KiB, SM_OM = 9728 * KiB, SM_ACT = 10240 * KiB, SM_SIDX = 11264 * KiB,
                 SM_SSQ = 11776 * KiB  , SM_T1 = 12288 * KiB, SM_SCORE = 13 * MiB  ;

constexpr int CW_BAR = 4096;

constexpr int RING_BYTES = 162816, LDSCTL_OFF = RING_BYTES, MISC_OFF = LDSCTL_OFF + 320, LDS_BYTES = 163840;

__device__ __forceinline__ unsigned f2bf(float f) { unsigned u = __builtin_bit_cast(unsigned, f); return (u + 0x7fffu + ((u >> 16) & 1u)) >> 16; }
__device__ __forceinline__ unsigned pk2(float lo, float hi) { return f2bf(lo) | (f2bf(hi) << 16); }
__device__ __forceinline__ float bf2f(unsigned short b) { return __builtin_bit_cast(float, (unsigned)b << 16); }
__device__ __forceinline__ float bflo(unsigned w) { return __builtin_bit_cast(float, w << 16); }
__device__ __forceinline__ float bfhi(unsigned w) { return __builtin_bit_cast(float, w & 0xffff0000u); }
__device__ __forceinline__ float wave_sum(float v) {
#pragma unroll
    for (int o = 1; o < 64; o <<= 1) v += __shfl_xor(v, o);
    return v;
}
__device__ __forceinline__ float wave_max(float v) {
#pragma unroll
    for (int o = 1; o < 64; o <<= 1) v = fmaxf(v, __shfl_xor(v, o));
    return v;
}
__device__ __forceinline__ float sigmoidf_(float x) { return 1.0f / (1.0f + __expf(-x)); }
__device__ __forceinline__ float siluf_(float x) { return x / (1.0f + __expf(-x)); }
__device__ __forceinline__ int crow(int r, int hi) { return (r & 3) + 8 * (r >> 2) + 4 * hi; }
__device__ __forceinline__ float lg2g(int h) { return __log2f(1.0f - exp2f(-5.0f - (float)h)); }

__host__ __device__ inline int idx_e(int y) {
    const int n = (y >> 4) & 1, fq = (y >> 2) & 3, j = y & 3;
    return fq < 2 ? 8 * n + 4 * fq + j : 16 + 8 * n + 4 * (fq - 2) + j;
}
__host__ __device__ inline int win_real_col(int v) {
    const int tile = v >> 8, x8 = v & 255, bj = x8 >> 7, x = x8 & 127;
    if (tile < 8) { const int wc = x >> 5, n = (x >> 4) & 1, r = x & 15; return tile * 256 + bj * 128 + 64 * n + 16 * wc + r; }
    if (tile < 22) return v;
    if (tile < 26) { const int y = x & 63; return 5632 + (tile - 22) * 256 + bj * 128 + (x & 64) + (y < 32 ? idx_e(y) : y); }
    if (tile == 26) { if (x8 < 64) return 6656 + (x8 < 32 ? idx_e(x8) : x8); if (x8 < 80) return 6720 + (x8 - 64); return -1; }
    if (tile < 35) return 6736 + (v - 27 * 256);
    return 8784 + (v - 35 * 256);
}
namespace pg8 {
#define PG8_LAS __attribute__((address_space(3)))
typedef unsigned short bf16_t;
typedef short bf16x8 __attribute__((ext_vector_type(8)));
typedef float f32x4 __attribute__((ext_vector_type(4)));
typedef unsigned u32x4 __attribute__((ext_vector_type(4)));
constexpr int BM = 256, BK = 64, HALF = 128, HTB = HALF * BK * 2  , STAGE_BYTES = 8 * HTB, NXCD = 8, WGM = 8;

__host__ __device__ __forceinline__ int lds_byte(int r, int c) { const int st = (r >> 4) * 2 + (c >> 5), rr = r & 15, cc = c & 31, ob = rr * 64 + cc * 2; return st * 1024 + (ob ^ (((ob >> 9) & 1) << 5)); }
__host__ __device__ __forceinline__ void stage_rc(int b, int& R, int& C) { const int st = b / 1024, sb = b % 1024, swz = sb ^ (((sb >> 9) & 1) << 5); R = (st >> 1) * 16 + swz / 64; C = (st & 1) * 32 + (swz % 64) / 2; }
__host__ __device__ __forceinline__ int perm32(int rho) { const int n = rho >> 4, i = rho & 15; return 8 * (i >> 2) + 4 * n + (i & 3); }

struct Unit { int pm, pn, pk; };
struct Gemm { const bf16_t* A; const bf16_t* Bt; int M, N, K, ld; };

struct StaticOrder {
    int nM, nN, nwg, G, c;
    __host__ __device__ void init(int M, int N, int G_, int c_) { nM = M / BM; nN = N / BM; nwg = nM * nN; G = G_; c = c_; }
    __host__ __device__ bool next(int i, Unit& u) const {
        const long L = (long)i * G + c; if (L >= nwg) return false;
        int wgid = (int)L; { const int q = nwg / NXCD, r = nwg % NXCD, xcd = wgid % NXCD, off = wgid / NXCD; wgid = (xcd < r ? xcd * (q + 1) : r * (q + 1) + (xcd - r) * q) + off; }
        const int nig = WGM * nN, gid = wgid / nig, fm = gid * WGM, gsz = (nM - fm) < WGM ? (nM - fm) : WGM;
        u.pm = fm + ((wgid % nig) % gsz); u.pn = (wgid % nig) / gsz; u.pk = 0; return true;
    }
    __device__ __forceinline__ void a_ready(const Unit&) const {}
    __device__ __forceinline__ void done(const Unit&) const {}
};


template <class Epi, class Sched, bool ALIGN_EPI = false, bool SP2 = false>
__device__ __forceinline__ void gemm_phase(PG8_LAS unsigned char* lds, const Gemm g, const Sched& S, const Epi& E) {
    const int tid = threadIdx.x, wid = __builtin_amdgcn_readfirstlane(tid >> 6), lane = tid & 63, wr = wid >> 2, wc = wid & 3, fr = lane & 15, fq = lane >> 4;
    const int K = g.K, nt = K / BK, ld = g.ld ? g.ld : g.K;
    unsigned voffA[2], voffB[2];
#pragma unroll
    for (int i = 0; i < 2; ++i) { int R, C; stage_rc(tid * 16 + i * 8192, R, C); const int Rb = Epi::PERM ? ((R & ~31) + perm32(R & 31)) : R;
        voffA[i] = (unsigned)(R * ld + C) * 2u; voffB[i] = (unsigned)(Rb * ld + C) * 2u; }
    const size_t kstep = (size_t)(BK * 2);
    const size_t hstep = (size_t)HALF * ld * 2;
    const size_t tstep = 2 * hstep;
    const unsigned ldsw = (unsigned)wid * 1024u;
    const int aoff = lds_byte(wr * 64 + fr, fq * 8), boff = lds_byte(wc * 32 + fr, fq * 8);
#define PG8_SA(b, h) (((b) * 2 + (h)) * HTB)
#define PG8_SB(b, h) ((4 + (b) * 2 + (h)) * HTB)
#define PG8_STAGE(bufoff, gbase, voff) do { _Pragma("unroll") for (int _i = 0; _i < 2; ++_i) \
        __builtin_amdgcn_global_load_lds((const unsigned*)((const char*)(gbase) + (voff)[_i]), (PG8_LAS unsigned*)(lds + (bufoff) + ldsw + _i * 8192), 16, 0, 0); } while (0)
#define PG8_LDA(dst, b, h) do { _Pragma("unroll") for (int m = 0; m < 4; ++m) _Pragma("unroll") for (int k = 0; k < 2; ++k) dst[m][k] = *(const PG8_LAS bf16x8*)(lds + PG8_SA(b, h) + aoff + m * 2048 + k * 1024); } while (0)
#define PG8_LDB(dst, b, h) do { _Pragma("unroll") for (int n = 0; n < 2; ++n) _Pragma("unroll") for (int k = 0; k < 2; ++k) dst[n][k] = *(const PG8_LAS bf16x8*)(lds + PG8_SB(b, h) + boff + n * 2048 + k * 1024); } while (0)
#define PG8_MMA(ai, bj, At, Bt) do { __builtin_amdgcn_s_setprio(1); _Pragma("unroll") for (int m = 0; m < 4; ++m) _Pragma("unroll") for (int n = 0; n < 2; ++n) _Pragma("unroll") for (int k = 0; k < 2; ++k) \
        acc[ai][bj][m][n] = __builtin_amdgcn_mfma_f32_16x16x32_bf16(Bt[n][k], At[m][k], acc[ai][bj][m][n], 0, 0, 0); __builtin_amdgcn_s_setprio(0); } while (0)
#define PG8_WAIT_V(n) asm volatile("s_waitcnt vmcnt(" #n ")" ::: "memory")
#define PG8_WAIT_L(n) asm volatile("s_waitcnt lgkmcnt(" #n ")" ::: "memory")
#define PG8_BAR __builtin_amdgcn_s_barrier()
#define PG8_SCHED __builtin_amdgcn_sched_barrier(0)
    Unit cur, nxt; int ui = 0;
    if (!S.next(0, cur)) return;
    f32x4 acc[2][2][4][2];
#pragma unroll
    for (int a = 0; a < 2; ++a)
#pragma unroll
        for (int b = 0; b < 2; ++b)
#pragma unroll
            for (int m = 0; m < 4; ++m)
#pragma unroll
                for (int n = 0; n < 2; ++n) acc[a][b][m][n] = (f32x4){0.f, 0.f, 0.f, 0.f};
    bf16x8 At[4][2], B0[2][2], B1[2][2];
    const char* cA = (const char*)g.A + (size_t)cur.pm * tstep + (size_t)cur.pk * K * 2; const char* cB = (const char*)g.Bt + (size_t)cur.pn * tstep + (size_t)cur.pk * K * 2;
    S.a_ready(cur);
    if constexpr (SP2) {
        PG8_STAGE(PG8_SB(0, 0), cB, voffB); PG8_STAGE(PG8_SB(0, 1), cB + hstep, voffB); PG8_STAGE(PG8_SA(0, 0), cA, voffA); PG8_STAGE(PG8_SA(0, 1), cA + hstep, voffA);
        if (wr == 1) PG8_BAR;
        PG8_WAIT_V(2); PG8_BAR;
        PG8_STAGE(PG8_SB(1, 0), cB + kstep, voffB); PG8_STAGE(PG8_SA(1, 0), cA + kstep, voffA); PG8_STAGE(PG8_SB(1, 1), cB + hstep + kstep, voffB);
        PG8_WAIT_V(6); PG8_BAR;
    } else {
        PG8_STAGE(PG8_SB(0, 0), cB, voffB); PG8_STAGE(PG8_SA(0, 0), cA, voffA); PG8_STAGE(PG8_SB(0, 1), cB + hstep, voffB); PG8_STAGE(PG8_SA(0, 1), cA + hstep, voffA);
        if (wr == 1) PG8_BAR;
        PG8_WAIT_V(4); PG8_BAR;
        PG8_STAGE(PG8_SB(1, 0), cB + kstep, voffB); PG8_STAGE(PG8_SA(1, 0), cA + kstep, voffA); PG8_STAGE(PG8_SB(1, 1), cB + hstep + kstep, voffB);
        PG8_WAIT_V(6); PG8_BAR;
    }
    for (;;) {
        const bool has_next = S.next(ui + 1, nxt);
        const char* nA = has_next ? (const char*)g.A + (size_t)nxt.pm * tstep + (size_t)nxt.pk * K * 2 : cA; const char* nB = has_next ? (const char*)g.Bt + (size_t)nxt.pn * tstep + (size_t)nxt.pk * K * 2 : cB;
        for (int t = 0; t < nt; t += 2) {
            const bool last = (t == nt - 2);
            const char* a1 = cA + (size_t)(t + 1) * kstep;
            const char* a2 = last ? nA : cA + (size_t)(t + 2) * kstep; const char* b2 = last ? nB : cB + (size_t)(t + 2) * kstep;
            const char* a3 = a2 + kstep; const char* b3 = b2 + kstep;
            if (last && has_next) S.a_ready(nxt);
            if constexpr (SP2) {
            PG8_LDB(B0, 0, 0); PG8_LDB(B1, 0, 1); PG8_SCHED; PG8_LDA(At, 0, 0); PG8_STAGE(PG8_SA(1, 1), a1 + hstep, voffA);
            PG8_WAIT_V(8); PG8_WAIT_L(0); PG8_BAR; PG8_MMA(0, 0, At, B0); PG8_MMA(0, 1, At, B1); PG8_BAR; PG8_SCHED;
            PG8_LDA(At, 0, 1); PG8_STAGE(PG8_SB(0, 0), b2, voffB); PG8_STAGE(PG8_SB(0, 1), b2 + hstep, voffB); PG8_STAGE(PG8_SA(0, 0), a2, voffA);
            PG8_WAIT_V(8); PG8_WAIT_L(0); PG8_BAR; PG8_MMA(1, 0, At, B0); PG8_MMA(1, 1, At, B1); PG8_BAR; PG8_SCHED;
            PG8_LDB(B0, 1, 0); PG8_LDB(B1, 1, 1); PG8_SCHED; PG8_LDA(At, 1, 0); PG8_STAGE(PG8_SA(0, 1), a2 + hstep, voffA);
            PG8_WAIT_V(8); PG8_WAIT_L(0); PG8_BAR; PG8_MMA(0, 0, At, B0); PG8_MMA(0, 1, At, B1); PG8_BAR; PG8_SCHED;
            PG8_LDA(At, 1, 1); PG8_STAGE(PG8_SB(1, 0), b3, voffB); PG8_STAGE(PG8_SB(1, 1), b3 + hstep, voffB); PG8_STAGE(PG8_SA(1, 0), a3, voffA);
            PG8_WAIT_V(8); PG8_WAIT_L(0); PG8_BAR; PG8_MMA(1, 0, At, B0); PG8_MMA(1, 1, At, B1); PG8_BAR; PG8_SCHED;
            } else {
            PG8_LDB(B0, 0, 0); PG8_SCHED; PG8_LDA(At, 0, 0); PG8_STAGE(PG8_SA(1, 1), a1 + hstep, voffA);
            PG8_WAIT_L(8); PG8_BAR; PG8_WAIT_L(0); PG8_MMA(0, 0, At, B0); PG8_BAR; PG8_SCHED;
            PG8_LDB(B1, 0, 1); PG8_STAGE(PG8_SB(0, 0), b2, voffB);
            PG8_BAR; PG8_WAIT_L(0); PG8_MMA(0, 1, At, B1); PG8_BAR;
            PG8_LDA(At, 0, 1); PG8_STAGE(PG8_SA(0, 0), a2, voffA);
            PG8_BAR; PG8_WAIT_L(0); PG8_MMA(1, 0, At, B0); PG8_BAR; PG8_SCHED;
            PG8_STAGE(PG8_SB(0, 1), b2 + hstep, voffB);
            PG8_WAIT_V(6); PG8_BAR; PG8_MMA(1, 1, At, B1); PG8_BAR;
            PG8_LDB(B0, 1, 0); PG8_SCHED; PG8_LDA(At, 1, 0); PG8_STAGE(PG8_SA(0, 1), a2 + hstep, voffA);
            PG8_WAIT_L(8); PG8_BAR; PG8_WAIT_L(0); PG8_MMA(0, 0, At, B0); PG8_BAR; PG8_SCHED;
            PG8_LDB(B1, 1, 1); PG8_STAGE(PG8_SB(1, 0), b3, voffB);
            PG8_BAR; PG8_WAIT_L(0); PG8_MMA(0, 1, At, B1); PG8_BAR;
            PG8_LDA(At, 1, 1); PG8_STAGE(PG8_SA(1, 0), a3, voffA);
            PG8_BAR; PG8_WAIT_L(0); PG8_MMA(1, 0, At, B0); PG8_BAR; PG8_SCHED;
            PG8_STAGE(PG8_SB(1, 1), b3 + hstep, voffB);
            PG8_WAIT_V(6); PG8_BAR; PG8_MMA(1, 1, At, B1); PG8_BAR;
            }
        }
        if constexpr (ALIGN_EPI) { if (wr == 0) PG8_BAR; }
        if constexpr (!Epi::AFTER_DRAIN) { E(acc, cur, wr, wc, fr, fq); S.done(cur); }
        if (!has_next) break;
        bool kept = false; if constexpr (Epi::KEEP) kept = E.keep(cur);
        if (!kept) {
#pragma unroll
        for (int a = 0; a < 2; ++a)
#pragma unroll
            for (int b = 0; b < 2; ++b)
#pragma unroll
                for (int m = 0; m < 4; ++m)
#pragma unroll
                    for (int n = 0; n < 2; ++n) acc[a][b][m][n] = (f32x4){0.f, 0.f, 0.f, 0.f};
        }
        cur = nxt; cA = nA; cB = nB; ++ui;
        if constexpr (ALIGN_EPI) { if (wr == 1) PG8_BAR; }
    }
    PG8_WAIT_V(0);
    if constexpr (!ALIGN_EPI) { if (wr == 0) PG8_BAR; }
    PG8_BAR;
    if constexpr (Epi::AFTER_DRAIN) { E.fused(acc, cur, wr, wc, fr, fq, lds, wid, lane); S.done(cur); }
#undef PG8_SA
#undef PG8_SB
#undef PG8_STAGE
#undef PG8_LDA
#undef PG8_LDB
#undef PG8_MMA
#undef PG8_WAIT_V
#undef PG8_WAIT_L
#undef PG8_BAR
#undef PG8_SCHED
}
}
#define XB_TMO      128
#define XB_XCNT(j)  (256  + 64 * (j))
#define XB_XSUB(j)  (1280 + 64 * (j))
#define XB_XGEN(j)  (2304 + 64 * (j))
#define XB_TOP      3328
#define XB_TOPGEN   3392
#define XCD_BAR_WORDS 3456
#define XB_SPIN_CAP (1u << 18)

__device__ __forceinline__ unsigned xb_ld(unsigned* p)              { return __hip_atomic_load(p, __ATOMIC_RELAXED, __HIP_MEMORY_SCOPE_AGENT); }
__device__ __forceinline__ unsigned xb_add(unsigned* p, unsigned v) { return __hip_atomic_fetch_add(p, v, __ATOMIC_RELAXED, __HIP_MEMORY_SCOPE_AGENT); }
__device__ __forceinline__ unsigned xb_xcc_id() { return (unsigned)__builtin_amdgcn_s_getreg((3 << 11) | 20) & 0xFu; }
#define XB_SPIN(cond, bar) do { unsigned _sp = 0; while (cond) { __builtin_amdgcn_s_sleep(1); \
    if ((++_sp & 255u) == 0u) { if (xb_ld(&(bar)[XB_TMO])) break; if (_sp > XB_SPIN_CAP) { atomicAdd(&(bar)[XB_TMO], 1u); break; } } } } while (0)

struct XcdBarrier {
    unsigned* bar; unsigned x;
    volatile LAS unsigned* st;
};

__device__ __forceinline__ XcdBarrier xcd_barrier_post(unsigned* bar, volatile LAS unsigned* st) {
    XcdBarrier b; b.bar = bar; b.x = xb_xcc_id(); b.st = st;
    if (threadIdx.x == 0) (void)xb_add(&bar[XB_XCNT(b.x)], 1u);
    return b;
}
__device__ __forceinline__ void xcd_barrier_complete(unsigned* bar, unsigned x, unsigned& nloc, unsigned& nx) {
    const unsigned G = gridDim.x * gridDim.y * gridDim.z;
    unsigned sum, cnt, mine, sp = 0u;
    for (;;) {
        sum = 0u; cnt = 0u; mine = 0u;
#pragma unroll
        for (unsigned j = 0; j < 16; ++j) { const unsigned c = xb_ld(&bar[XB_XCNT(j)]); sum += c; cnt += (c > 0u) ? 1u : 0u; mine = (j == x) ? c : mine; }
        if (sum == G) break;
        __builtin_amdgcn_s_sleep(1);
        if ((++sp & 255u) == 0u) { if (xb_ld(&bar[XB_TMO])) break; if (sp > XB_SPIN_CAP) { atomicAdd(&bar[XB_TMO], 1u); break; } }
    }
    nloc = mine > 0u ? mine : 1u; nx = cnt > 0u ? cnt : 1u;
}

__device__ __forceinline__ void xcd_barrier(const XcdBarrier& b) {
    asm volatile("s_waitcnt vmcnt(0)" ::: "memory");
    __syncthreads();
    if (threadIdx.x == 0) {
        unsigned* bar = b.bar;
        __builtin_amdgcn_s_waitcnt(0);
        unsigned nloc = b.st[0], nx = b.st[1];
        if (nloc == 0u) { xcd_barrier_complete(bar, b.x, nloc, nx); b.st[0] = nloc; b.st[1] = nx; }
        const unsigned old = xb_add(&bar[XB_XSUB(b.x)], 1u);
        const unsigned gen = old / nloc;
        if (old + 1u == (gen + 1u) * nloc) {
            __builtin_amdgcn_fence(__ATOMIC_RELEASE, "agent");
            asm volatile("s_waitcnt vmcnt(0)" ::: "memory");
            const unsigned og = xb_add(&bar[XB_TOP], 1u);
            const unsigned tg = og / nx;
            if (og + 1u == (tg + 1u) * nx) xb_add(&bar[XB_TOPGEN], 1u);
            else XB_SPIN(xb_ld(&bar[XB_TOPGEN]) == tg, bar);
            __builtin_amdgcn_fence(__ATOMIC_ACQUIRE, "agent");
            xb_add(&bar[XB_XGEN(b.x)], 1u);
            asm volatile("s_waitcnt vmcnt(0)" ::: "memory");
        } else {
            XB_SPIN(xb_ld(&bar[XB_XGEN(b.x)]) == gen, bar);
            __builtin_amdgcn_fence(__ATOMIC_ACQUIRE, "agent");
            asm volatile("s_waitcnt vmcnt(0)" ::: "memory");
        }
    }
    __syncthreads();
}

typedef GAS unsigned gu32;
#define RLX_AGENT __ATOMIC_RELAXED, __HIP_MEMORY_SCOPE_AGENT
#define LDS_WAIT() asm volatile("s_waitcnt lgkmcnt(0)" ::: "memory")
#define VM_WAIT() asm volatile("s_waitcnt vmcnt(0)" ::: "memory")
constexpr int NWAVES = 8;

struct Frame {
    LAS unsigned char* lds;
    unsigned char* ws; float* out;
    const void* const* in;
    int tid, lane, wave, vcu, G;
};
struct Args { const void* in[26]; float* out; unsigned char* ws; int ph_lo, ph_hi; };

enum { I_XP = 0, I_XS, I_MEMP, I_CK, I_CV, I_CIK, I_STATE, I_CMK, I_CMV, I_PT, I_GMIX, I_WIN, I_GNRET, I_WRO, I_WDO, I_WO, I_GMEM, I_GMEMKV, I_WMQ, I_WMK, I_WMV, I_WMO, I_GMLP, I_WUP, I_WDN, I_GFINAL };

__device__ __forceinline__ void p0_transpose_item(const float* W, int ldw, int k0, int rc4, const float* g, bf16_t* WT, int ldt, int vrow0, LAS unsigned char* scr, int lane) {
    const int nq = lane & 15, kq = lane >> 4;
    const float* src = W + (size_t)(k0 + 16 * kq) * ldw + (rc4 < 0 ? 0 : rc4);
    f32x4 x[16];
#pragma unroll
    for (int i = 0; i < 16; ++i) x[i] = *(const GAS f32x4*)(src + (size_t)i * ldw);
    if (g) {
#pragma unroll
        for (int i = 0; i < 16; ++i) x[i] = x[i] * g[k0 + 16 * kq + i];
    }
    if (rc4 < 0) {
#pragma unroll
        for (int i = 0; i < 16; ++i) x[i] = (f32x4){0.f, 0.f, 0.f, 0.f};
    }
#pragma unroll
    for (int e = 0; e < 4; ++e) {
        u32x4 w0, w1;
        w0.x = pk2(x[0][e], x[1][e]); w0.y = pk2(x[2][e], x[3][e]); w0.z = pk2(x[4][e], x[5][e]); w0.w = pk2(x[6][e], x[7][e]);
        w1.x = pk2(x[8][e], x[9][e]); w1.y = pk2(x[10][e], x[11][e]); w1.z = pk2(x[12][e], x[13][e]); w1.w = pk2(x[14][e], x[15][e]);
        LAS unsigned char* row = scr + (4 * nq + e) * 128;
        *(LAS u32x4*)(row + (((2 * kq) ^ (nq & 7)) * 16)) = w0; *(LAS u32x4*)(row + (((2 * kq + 1) ^ (nq & 7)) * 16)) = w1;
    }
    LDS_WAIT(); asm volatile("" ::: "memory");
    const int c = lane & 7;
#pragma unroll
    for (int j = 0; j < 8; ++j) { const int n = (lane >> 3) + 8 * j; const u32x4 v = *(const LAS u32x4*)(scr + n * 128 + ((c ^ ((n >> 2) & 7)) * 16));
        *(GAS u32x4*)(WT + (size_t)(vrow0 + n) * ldt + k0 + 8 * c) = v; }
    LDS_WAIT(); asm volatile("" ::: "memory");
}
__device__ __forceinline__ void rms_row_to_bf16(const float* xrow, const float* g, bf16_t* orow, int lane) {
    const GAS f32x4* xr = (const GAS f32x4*)xrow + lane; const GAS f32x4* gr = (const GAS f32x4*)g + lane;
    f32x4 v[8]; float s = 0.f;
#pragma unroll
    for (int j = 0; j < 8; ++j) { v[j] = xr[64 * j]; s += (v[j].x * v[j].x + v[j].y * v[j].y) + (v[j].z * v[j].z + v[j].w * v[j].w); }
    const float rstd = 1.0f / sqrtf(wave_sum(s) * (1.0f / DM) + EPS);
    GAS u32x2* o8 = (GAS u32x2*)orow + lane;
#pragma unroll
    for (int j = 0; j < 8; ++j) { const f32x4 gg = gr[64 * j]; u32x2 w; w.x = pk2(v[j].x * rstd * gg.x, v[j].y * rstd * gg.y); w.y = pk2(v[j].z * rstd * gg.z, v[j].w * rstd * gg.w); o8[64 * j] = w; }
}
__device__ __forceinline__ void p0_prologue(Frame& F, const Args& A) {
    LAS unsigned char* scr = F.lds + F.wave * 8192;
    const int gw = F.vcu * NWAVES + F.wave, NGW = F.G * NWAVES, lane = F.lane, nq4 = 4 * (lane & 15);
    unsigned char* ws = F.ws;
    constexpr int I_IN = 32 * (12032 / 64);
    constexpr int I_RO = 16 * 32, I_DOO = 16 * 32, I_O = 32 * 32, I_MQ = 32 * 8, I_MO = 8 * 32, I_UP = 32 * 128, I_DN = 128 * 32;
    constexpr int NITEMS = I_IN + I_RO + I_DOO + I_O + I_MQ + I_MO + I_UP + I_DN;
    for (int it = gw; it < NITEMS; it += NGW) {
        int r = it;
        if (r < I_IN) { const int vg = r >> 5, kb = r & 31, v0 = vg * 64;
            if (v0 < NV1) p0_transpose_item((const float*)A.in[I_WIN], NIN, kb * 64, win_real_col(v0 + nq4), nullptr, (bf16_t*)(ws + WS_WT1), DM, v0, scr, lane);
            else if (v0 < NV1 + 512) p0_transpose_item((const float*)A.in[I_WMK], MEMW, kb * 64, v0 - NV1 + nq4, nullptr, (bf16_t*)(ws + WS_WT1), DM, v0, scr, lane);
            else p0_transpose_item((const float*)A.in[I_WMV], MEMW, kb * 64, v0 - NV1 - 512 + nq4, nullptr, (bf16_t*)(ws + WS_WT1), DM, v0, scr, lane);
            continue; } r -= I_IN;
        if (r < I_RO) { const int vg = r >> 4, kb = r & 15; p0_transpose_item((const float*)A.in[I_WRO], DM, kb * 64, vg * 64 + nq4, nullptr, (bf16_t*)(ws + WS_WRO), 1024, vg * 64, scr, lane); continue; } r -= I_RO;
        if (r < I_DOO) { const int vg = r >> 4, kb = r & 15; p0_transpose_item((const float*)A.in[I_WDO], DM, kb * 64, vg * 64 + nq4, nullptr, (bf16_t*)(ws + WS_WDO), 1024, vg * 64, scr, lane); continue; } r -= I_DOO;
        if (r < I_O) { const int vg = r >> 5, kb = r & 31; p0_transpose_item((const float*)A.in[I_WO], DM, kb * 64, vg * 64 + nq4, nullptr, (bf16_t*)(ws + WS_WO), DM, vg * 64, scr, lane); continue; } r -= I_O;
        if (r < I_MQ) { const int vg = r >> 5, kb = r & 31; p0_transpose_item((const float*)A.in[I_WMQ], MEMW, kb * 64, vg * 64 + nq4, (const float*)A.in[I_GMEM], (bf16_t*)(ws + WS_WMQ), DM, vg * 64, scr, lane); continue; } r -= I_MQ;
        if (r < I_MO) { const int vg = r >> 3, kb = r & 7; p0_transpose_item((const float*)A.in[I_WMO], DM, kb * 64, vg * 64 + nq4, nullptr, (bf16_t*)(ws + WS_WMO), MEMW, vg * 64, scr, lane); continue; } r -= I_MO;
        if (r < I_UP) { const int vg = r >> 5, kb = r & 31; p0_transpose_item((const float*)A.in[I_WUP], DFF, kb * 64, vg * 64 + nq4, (const float*)A.in[I_GMLP], (bf16_t*)(ws + WS_WUP), DM, vg * 64, scr, lane); continue; } r -= I_UP;
        { const int vg = r >> 7, kb = r & 127; p0_transpose_item((const float*)A.in[I_WDN], DM, kb * 64, vg * 64 + nq4, nullptr, (bf16_t*)(ws + WS_WDN), DFF, vg * 64, scr, lane); }
    }
    for (int m = gw; m < MP + 512 + MS; m += NGW) {
        if (m < MP) rms_row_to_bf16((const float*)A.in[I_XP] + (size_t)m * DM, (const float*)A.in[I_GMIX], (bf16_t*)(ws + WS_XN) + (size_t)m * DM, lane);
        else if (m < MP + 512) rms_row_to_bf16((const float*)A.in[I_MEMP] + (size_t)(m - MP) * DM, (const float*)A.in[I_GMEMKV], (bf16_t*)(ws + WS_XN) + (size_t)m * DM, lane);
        else rms_row_to_bf16((const float*)A.in[I_XS] + (size_t)(m - MP - 512) * DM, (const float*)A.in[I_GMIX], (bf16_t*)(ws + WS_SMP + SM_XN) + (size_t)(m - MP - 512) * DM, lane);
    }
    {
        const int gt = F.vcu * (NWAVES * 64) + F.tid, NGT = F.G * NWAVES * 64;
        float* c64 = (float*)(ws + WS_TAB + TAB_COS64); float* s64 = (float*)(ws + WS_TAB + TAB_SIN64);
        float* c16 = (float*)(ws + WS_TAB + TAB_COS16); float* s16 = (float*)(ws + WS_TAB + TAB_SIN16);
        float* c8 = (float*)(ws + WS_TAB + TAB_COS8); float* s8 = (float*)(ws + WS_TAB + TAB_SIN8);
        for (int e = gt; e < NTPOS * 88; e += NGT) {
            const int tp = e / 88, i = e % 88; const float pos = (float)(tp < SEQ ? tp : PAST + (tp - SEQ));
            float inv; float* cd; float* sd;
            if (i < 64) { inv = powf(10000.0f, -(float)i / 64.0f); cd = c64 + tp * 64 + i; sd = s64 + tp * 64 + i; }
            else if (i < 80) { inv = powf(500000.0f, -(float)(i - 64) / 16.0f); cd = c16 + tp * 16 + (i - 64); sd = s16 + tp * 16 + (i - 64); }
            else { inv = powf(500000.0f, -(float)(i - 80) / 8.0f); cd = c8 + tp * 8 + (i - 80); sd = s8 + tp * 8 + (i - 80); }
            const float ang = pos * inv; float sn, cs; sincosf(ang, &sn, &cs); *cd = cs; *sd = sn;
        }
        for (int e = gt; e < 3 * MP; e += NGT) ((float*)(ws + WS_SSQ + (size_t)(e / MP) * MiB))[e % MP] = 0.f;
        const float* cmk = (const float*)A.in[I_CMK]; const float* cmv = (const float*)A.in[I_CMV];
        bf16_t* kb = (bf16_t*)(ws + WS_MEMKB) + 2 * 256 * 512; bf16_t* vb = (bf16_t*)(ws + WS_MEMVB) + 2 * 256 * 512;
        for (int e = gt; e < 2 * 8 * 256 * 512 / 4; e += NGT) {
            const int half = 8 * 256 * 512 / 4; const bool isv = e >= half; const int j = isv ? e - half : e;
            const f32x4 x = *((const GAS f32x4*)(isv ? cmv : cmk) + j); u32x2 w; w.x = pk2(x.x, x.y); w.y = pk2(x.z, x.w);
            *((GAS u32x2*)(isv ? vb : kb) + j) = w;
        }
    }
}
struct OrderX : pg8::StaticOrder {
    int nextra, xm0, xn0, xn;
    __device__ void initx(int M, int N, int G_, int c_, int nextra_, int xm0_, int xn0_, int xn_) { init(M, N, G_, c_); nextra = nextra_; xm0 = xm0_; xn0 = xn0_; xn = xn_; }
    __device__ bool next(int i, pg8::Unit& u) const {
        const long L = (long)i * G + c;
        if (L < nwg) return pg8::StaticOrder::next(i, u);
        const int e = (int)(L - nwg); if (e >= nextra) return false;
        u.pm = xm0 + e / xn; u.pn = xn0 + e % xn; u.pk = 0; return true;
    }
};
struct OrderDual : pg8::StaticOrder {
    __device__ bool next(int i, pg8::Unit& u) const {
        if (i >= 2) return false; if (!pg8::StaticOrder::next(0, u)) return false;
        if (i == 0) { u.pm += 32; u.pn += 8; } return true;
    }
};

struct OrderSplitK {
    int nM, nN, nK, G, c;
    __device__ bool next(int i, pg8::Unit& u) const { const int L = i * G + c; if (L >= nM * nN * nK) return false; u.pk = L % nK; u.pn = (L / nK) % nN; u.pm = L / (nK * nN); return true; }
    __device__ __forceinline__ void a_ready(const pg8::Unit&) const {}
    __device__ __forceinline__ void done(const pg8::Unit&) const {}
};
__device__ __forceinline__ f32x16 skinny_partial(const bf16_t* A, int lda, const bf16_t* Wt, int K, int nb, int wave, int lane) {
    const int r32 = lane & 31, hi = lane >> 5, kw = K / 8;
    const bf16_t* ap = A + (size_t)r32 * lda + wave * kw + 8 * hi; const bf16_t* bp = Wt + (size_t)(nb * 32 + r32) * K + wave * kw + 8 * hi;
    f32x16 acc = {};
    for (int k = 0; k < kw; k += 64) {
        bf16x8 a[4], b[4];
#pragma unroll
        for (int i = 0; i < 4; ++i) { a[i] = *(const GAS bf16x8*)(ap + k + 16 * i); b[i] = *(const GAS bf16x8*)(bp + k + 16 * i); }
#pragma unroll
        for (int i = 0; i < 4; ++i) acc = __builtin_amdgcn_mfma_f32_32x32x16_bf16(a[i], b[i], acc, 0, 0, 0);
    }
    return acc;
}
__device__ __forceinline__ void skinny_reduce(const f32x16& acc, LAS float* red, int wave, int lane, int tid, float& v1, float& v2) {
    const int r32 = lane & 31, hi = lane >> 5;
    __syncthreads();
#pragma unroll
    for (int r = 0; r < 16; ++r) red[wave * 1024 + crow(r, hi) * 32 + r32] = acc[r];
    __syncthreads();
    const int row = tid >> 4, c = tid & 15; v1 = 0.f; v2 = 0.f;
#pragma unroll
    for (int w = 0; w < 8; ++w) { v1 += red[w * 1024 + row * 32 + c]; v2 += red[w * 1024 + row * 32 + 16 + c]; }
}
__device__ __forceinline__ float sum16(float v) { v += __shfl_xor(v, 1); v += __shfl_xor(v, 2); v += __shfl_xor(v, 4); v += __shfl_xor(v, 8); return v; }

#define PB(off) ((bf16_t*)(ws + (off)))
#define PF(off) ((float*)(ws + (off)))
#define TABF(off) ((const float*)(ws + WS_TAB + (off)))
__device__ __forceinline__ void st_bf4(bf16_t* p, f32x4 v) { u32x2 w; w.x = pk2(v.x, v.y); w.y = pk2(v.z, v.w); *(GAS u32x2*)p = w; }

struct EpiIn {
    static constexpr bool PERM = false, AFTER_DRAIN = false, KEEP = false;
    unsigned char* ws; float* out;
    __device__ __forceinline__ void operator()(const f32x4 (&acc)[2][2][4][2], const pg8::Unit& u, int wr, int wc, int fr, int fq) const {
        const int pn = u.pn; const int rowb = u.pm * 256 + wr * 64 + fr; const int x0 = 32 * wc + 4 * fq;
        size_t boff = 0, foff = 0, tcoff = 0, tsoff = 0; bool hasf = false; int ld = 1024, act = 0, deck = 0, tstr = 0, toff = 0, rsub = 0; bool rot = false;
        int c1[2] = {x0, 128 + x0}, c2[2] = {x0 + 16, 128 + x0 + 16}; float l2[2] = {0.f, 0.f};
        if (pn < 8) { boff = pn < 4 ? WS_RQ : WS_RK; deck = pn < 4 ? 1 : 2; tstr = 64; tcoff = TAB_COS64; tsoff = TAB_SIN64; rot = true; toff = 16 * wc + 4 * fq;
            c1[0] = ((pn & 3) * 2) * 128 + toff; c1[1] = c1[0] + 128; c2[0] = c1[0] + 64; c2[1] = c1[1] + 64; l2[0] = lg2g((pn & 3) * 2); l2[1] = lg2g((pn & 3) * 2 + 1); }
        else if (pn < 16) { boff = pn < 12 ? WS_RV : WS_RG; act = pn < 12 ? 0 : 1; const int cb = (pn & 3) * 256; c1[0] += cb; c1[1] += cb; c2[0] += cb; c2[1] += cb; }
        else if (pn < 22) { tstr = 16; tcoff = TAB_COS16; tsoff = TAB_SIN16; rot = (wc == 0) && pn != 21; toff = 4 * fq;
            if (pn < 20) { boff = WS_DQ; const int cb = (pn - 16) * 256; c1[0] += cb; c1[1] += cb; c2[0] += cb; c2[1] += cb; }
            else { boff = pn == 20 ? WS_DK : WS_DV; foff = pn == 20 ? O_KP : O_VP; hasf = true; ld = 256; } }
        else if (pn < 27) { tstr = 8; tcoff = TAB_COS8; tsoff = TAB_SIN8; const bool low = (wc & 1) == 0; rot = low && fq < 2; toff = 4 * (fq & 1);
            const int e0 = low ? (fq < 2 ? 4 * fq : 16 + 4 * (fq - 2)) : 32 + 4 * fq, e1 = low ? e0 + 8 : e0 + 16;
            if (pn < 26) { boff = WS_IQ; const int hb = ((pn - 22) * 4 + (wc >> 1)) * 64; c1[0] = hb + e0; c2[0] = hb + e1; c1[1] = hb + 128 + e0; c2[1] = hb + 128 + e1; }
            else { boff = WS_IK; foff = O_IKP; hasf = true; ld = 64; c1[0] = wc < 2 ? e0 : -1; c2[0] = e1; c1[1] = -1; } }
        else if (pn < 43) { const bool isb = pn >= 35; boff = isb ? WS_GB : WS_GA; act = 2; ld = 2048; const int cb = (pn - (isb ? 35 : 27)) * 256; c1[0] += cb; c1[1] += cb; c2[0] += cb; c2[1] += cb; }
        else { const bool isv = pn >= 45; boff = isv ? WS_MEMVB : WS_MEMKB; foff = isv ? O_MV : O_MK; hasf = true; ld = 512; rsub = MP; const int cb = ((pn - 43) & 1) * 256; c1[0] += cb; c1[1] += cb; c2[0] += cb; c2[1] += cb; }
        bf16_t* bd = (bf16_t*)(ws + boff); float* fd = out + foff; const float* tcs = (const float*)(ws + WS_TAB + tcoff) + toff; const float* tsn = (const float*)(ws + WS_TAB + tsoff) + toff;
        if (pn == 26 && wc == 2) {
#pragma unroll
            for (int ai = 0; ai < 2; ++ai)
#pragma unroll
                for (int m = 0; m < 4; ++m) *(GAS f32x4*)((float*)(ws + WS_IW) + (size_t)(rowb + ai * 128 + m * 16) * 16 + 4 * fq) = acc[ai][0][m][0];
        }
#pragma unroll
        for (int ai = 0; ai < 2; ++ai)
#pragma unroll
            for (int m = 0; m < 4; ++m) { const int row = rowb + ai * 128 + m * 16, tp = row & (SEQ - 1); const size_t ro = (size_t)(row - rsub) * ld;
                f32x4 cs = {1.f, 1.f, 1.f, 1.f}, sn = {0.f, 0.f, 0.f, 0.f};
                if (rot) { cs = *(const GAS f32x4*)(tcs + tp * tstr); sn = *(const GAS f32x4*)(tsn + tp * tstr); }
                const float cif = (float)((row & 127) + 1);
#pragma unroll
                for (int bj = 0; bj < 2; ++bj) { if (c1[bj] < 0) continue;
                    const f32x4 x1 = acc[ai][bj][m][0], x2 = acc[ai][bj][m][1];
                    f32x4 o1 = x1 * cs - x2 * sn, o2 = x2 * cs + x1 * sn;
                    if (deck) { const float dec = deck == 1 ? exp2f(cif * l2[bj]) : exp2f(-cif * l2[bj]) * QK_SCALE; o1 = o1 * dec; o2 = o2 * dec; }
                    if (act == 1) { o1.x = siluf_(o1.x); o1.y = siluf_(o1.y); o1.z = siluf_(o1.z); o1.w = siluf_(o1.w); o2.x = siluf_(o2.x); o2.y = siluf_(o2.y); o2.z = siluf_(o2.z); o2.w = siluf_(o2.w); }
                    else if (act == 2) { o1.x = sigmoidf_(o1.x); o1.y = sigmoidf_(o1.y); o1.z = sigmoidf_(o1.z); o1.w = sigmoidf_(o1.w); o2.x = sigmoidf_(o2.x); o2.y = sigmoidf_(o2.y); o2.z = sigmoidf_(o2.z); o2.w = sigmoidf_(o2.w); }
                    st_bf4(bd + ro + c1[bj], o1); st_bf4(bd + ro + c2[bj], o2);
                    if (hasf) { *(GAS f32x4*)(fd + ro + c1[bj]) = o1; *(GAS f32x4*)(fd + ro + c2[bj]) = o2; } }
                asm volatile("" ::: "memory"); }
    }
};

__device__ __forceinline__ void st1(bf16_t* p, float v) { *(GAS bf16_t*)p = (bf16_t)f2bf(v); }
__device__ __forceinline__ void epi_in_sample(unsigned char* ws, float* out, int row, int nb, int c, float v1, float v2) {
    const int pn = nb >> 3, bj = (nb >> 2) & 1, wc = nb & 3, t = row & 3, tp = SEQ + t, fq = c >> 2, j = c & 3;
    if (pn < 8) { const bool isk = pn >= 4; const int head = (pn & 3) * 2 + bj, i = 16 * wc + c; const float l2 = lg2g(head);
        const float cs = TABF(TAB_COS64)[tp * 64 + i], sn = TABF(TAB_SIN64)[tp * 64 + i], dec = isk ? exp2f(-(float)(t + 1) * l2) * QK_SCALE : exp2f((float)(t + 1) * l2);
        bf16_t* o = PB(WS_SMP + (isk ? SM_RK : SM_RQ)) + (size_t)row * 1024 + head * 128 + i;
        st1(o, (v1 * cs - v2 * sn) * dec); st1(o + 64, (v2 * cs + v1 * sn) * dec);
    } else if (pn < 16) { const bool isg = pn >= 12; bf16_t* o = PB(WS_SMP + (isg ? SM_RG : SM_RV)) + (size_t)row * 1024 + (pn & 3) * 256 + bj * 128 + 32 * wc + c;
        st1(o, isg ? siluf_(v1) : v1); st1(o + 16, isg ? siluf_(v2) : v2);
    } else if (pn < 22) { const bool isq = pn < 20, isv = pn == 21; const int ld = isq ? 1024 : 256; const size_t off = (size_t)row * ld + (isq ? (pn - 16) * 256 : 0) + bj * 128 + 32 * wc + c;
        float cs = 1.f, sn = 0.f; if (wc == 0 && !isv) { cs = TABF(TAB_COS16)[tp * 16 + c]; sn = TABF(TAB_SIN16)[tp * 16 + c]; }
        const float o1 = v1 * cs - v2 * sn, o2 = v2 * cs + v1 * sn; bf16_t* dst = PB(WS_SMP + (isq ? SM_DQ : (isv ? SM_DV : SM_DK)));
        st1(dst + off, o1); st1(dst + off + 16, o2);
        if (!isq) { float* fo = out + (isv ? O_VS : O_KS); fo[off] = o1; fo[off + 16] = o2; }
    } else if (pn < 27) {
        if (pn == 26 && (bj == 1 || wc > 2)) return;
        if (pn == 26 && wc == 2) { PF(WS_SMP + SM_IW)[row * 16 + c] = v1; return; }
        const bool low = (wc & 1) == 0; const bool rot = low && fq < 2;
        float cs = 1.f, sn = 0.f; if (rot) { cs = TABF(TAB_COS8)[tp * 8 + c]; sn = TABF(TAB_SIN8)[tp * 8 + c]; }
        const float o1 = v1 * cs - v2 * sn, o2 = v2 * cs + v1 * sn;
        const int e0 = (low ? (fq < 2 ? 4 * fq : 16 + 4 * (fq - 2)) : 32 + 4 * fq) + j, e1 = low ? e0 + 8 : e0 + 16;
        if (pn < 26) { bf16_t* o = PB(WS_SMP + SM_IQ) + (size_t)row * 1024 + ((pn - 22) * 4 + 2 * bj + (wc >> 1)) * 64; st1(o + e0, o1); st1(o + e1, o2); }
        else { st1(PB(WS_SMP + SM_IK) + row * 64 + e0, o1); st1(PB(WS_SMP + SM_IK) + row * 64 + e1, o2); out[O_IKS + row * 64 + e0] = o1; out[O_IKS + row * 64 + e1] = o2; }
    } else { const bool isb = pn >= 35; bf16_t* o = PB(WS_SMP + (isb ? SM_GB : SM_GA)) + (size_t)row * 2048 + (pn - (isb ? 35 : 27)) * 256 + bj * 128 + 32 * wc + c;
        st1(o, sigmoidf_(v1)); st1(o + 16, sigmoidf_(v2)); }
}
__device__ __forceinline__ void d1_unit(Frame& F, int b, int qb, int kb) {
    const int lane = F.lane, wave = F.wave, r32 = lane & 31, hi = lane >> 5, qs = wave & 3, kh = wave >> 2;
    const bf16_t* IQ = (const bf16_t*)(F.ws + WS_IQ); const bf16_t* IK = (const bf16_t*)(F.ws + WS_IK); const float* IW = (const float*)(F.ws + WS_IW);
    float* SC = (float*)(F.ws + WS_SCORES);
    LAS float* wl = (LAS float*)(F.lds) + wave * 512;
    const int q0 = b * SEQ + qb * 128 + qs * 32, k0 = b * SEQ + kb * 128 + kh * 64;
    __syncthreads();
    {
        const GAS f32x4* src = (const GAS f32x4*)(IW + (size_t)q0 * 16) + lane * 2;
        const f32x4 a = src[0], c = src[1]; const int q = lane >> 1, h0 = (lane & 1) * 8;
        wl[(h0 + 0) * 32 + q] = a.x; wl[(h0 + 1) * 32 + q] = a.y; wl[(h0 + 2) * 32 + q] = a.z; wl[(h0 + 3) * 32 + q] = a.w;
        wl[(h0 + 4) * 32 + q] = c.x; wl[(h0 + 5) * 32 + q] = c.y; wl[(h0 + 6) * 32 + q] = c.z; wl[(h0 + 7) * 32 + q] = c.w;
    }
    bf16x8 bk[2][4];
#pragma unroll
    for (int cb = 0; cb < 2; ++cb)
#pragma unroll
        for (int ks = 0; ks < 4; ++ks) bk[cb][ks] = *(const GAS bf16x8*)(IK + (size_t)(k0 + cb * 32 + r32) * 64 + ks * 16 + 8 * hi);
    const bf16_t* aq = IQ + (size_t)(q0 + r32) * 1024 + 8 * hi;
    bf16x8 an[4];
#pragma unroll
    for (int ks = 0; ks < 4; ++ks) an[ks] = *(const GAS bf16x8*)(aq + ks * 16);
    f32x16 s0 = {}, s1 = {};
    LDS_WAIT();
    for (int h = 0; h < 16; ++h) {
        bf16x8 a[4];
#pragma unroll
        for (int ks = 0; ks < 4; ++ks) a[ks] = an[ks];
        if (h < 15) {
#pragma unroll
            for (int ks = 0; ks < 4; ++ks) an[ks] = *(const GAS bf16x8*)(aq + (h + 1) * 64 + ks * 16);
        }
        f32x16 d0 = {}, d1 = {};
#pragma unroll
        for (int ks = 0; ks < 4; ++ks) { d0 = __builtin_amdgcn_mfma_f32_32x32x16_bf16(a[ks], bk[0][ks], d0, 0, 0, 0); d1 = __builtin_amdgcn_mfma_f32_32x32x16_bf16(a[ks], bk[1][ks], d1, 0, 0, 0); }
        f32x4 wv[4];
#pragma unroll
        for (int g = 0; g < 4; ++g) wv[g] = *(const LAS f32x4*)(wl + h * 32 + 8 * g + 4 * hi);
#pragma unroll
        for (int r = 0; r < 16; ++r) { const float w = wv[r >> 2][r & 3]; s0[r] = fmaf(fmaxf(d0[r], 0.f), w, s0[r]); s1[r] = fmaf(fmaxf(d1[r], 0.f), w, s1[r]); }
    }
#pragma unroll
    for (int r = 0; r < 16; ++r) { float* o = SC + (size_t)(q0 + crow(r, hi)) * SEQ + (kb * 128 + kh * 64 + r32); o[0] = s0[r]; o[32] = s1[r]; }
}

typedef short v4i16_t __attribute__((ext_vector_type(4)));
__device__ __forceinline__ bf16x8 tr_frag(const LAS bf16_t* T, int ld, int k0, int c0, int lane) {
    const LAS bf16_t* p = T + (k0 + 8 * (lane >> 5) + ((lane & 15) >> 2)) * ld + c0 + 16 * ((lane >> 4) & 1) + 4 * (lane & 3);
    const v4i16_t lo = __builtin_amdgcn_ds_read_tr16_b64_v4i16((LAS v4i16_t*)p);
    const v4i16_t hh = __builtin_amdgcn_ds_read_tr16_b64_v4i16((LAS v4i16_t*)(p + 4 * ld));
    return (bf16x8){lo[0], lo[1], lo[2], lo[3], hh[0], hh[1], hh[2], hh[3]};
}
constexpr int TLD = 160;
__device__ __forceinline__ void stage_tile128(const bf16_t* g, int gld, LAS bf16_t* T, int tid) {
    const int row = tid >> 2, q = tid & 3;
    const GAS u32x4* src = (const GAS u32x4*)(g + (size_t)row * gld + q * 32);
    const u32x4 a = src[0], b = src[1], c = src[2], d = src[3];
    LAS u32x4* dst = (LAS u32x4*)(T + row * TLD + q * 32);
    dst[0] = a; dst[1] = b; dst[2] = c; dst[3] = d;
}

__device__ __forceinline__ void r1_unit(Frame& F, int bh, int n) {
    const int lane = F.lane, wave = F.wave, r32 = lane & 31, hi = lane >> 5, b = bh >> 3, h = bh & 7;
    LAS bf16_t* Vt = (LAS bf16_t*)F.lds; LAS bf16_t* Kt = Vt + 128 * TLD;
    const size_t row0 = (size_t)b * SEQ + n * 128;
    __syncthreads();
    stage_tile128((const bf16_t*)(F.ws + WS_RV) + row0 * 1024 + h * 128, 1024, Vt, F.tid);
    stage_tile128((const bf16_t*)(F.ws + WS_RK) + row0 * 1024 + h * 128, 1024, Kt, F.tid);
    __syncthreads();
    const int dvb = wave & 3, dkh = wave >> 2;
    f32x16 acc0 = {}, acc1 = {};
#pragma unroll
    for (int ks = 0; ks < 8; ++ks) {
        const bf16x8 a = tr_frag(Vt, TLD, 16 * ks, 32 * dvb, lane);
        const bf16x8 b0 = tr_frag(Kt, TLD, 16 * ks, 64 * dkh, lane), b1 = tr_frag(Kt, TLD, 16 * ks, 64 * dkh + 32, lane);
        acc0 = __builtin_amdgcn_mfma_f32_32x32x16_bf16(a, b0, acc0, 0, 0, 0); acc1 = __builtin_amdgcn_mfma_f32_32x32x16_bf16(a, b1, acc1, 0, 0, 0);
    }
    float* o = (float*)(F.ws + WS_KVC) + ((size_t)bh * 32 + n) * 16384;
#pragma unroll
    for (int r = 0; r < 16; ++r) { float* p = o + (32 * dvb + crow(r, hi)) * 128 + 64 * dkh + r32; p[0] = acc0[r]; p[32] = acc1[r]; }
}

__device__ __forceinline__ void s1_unit(Frame& F, const Args& A, int b, int c) {
    const int lane = F.lane, wave = F.wave, r32 = lane & 31, hi = lane >> 5;
    const bf16_t* IQ = (const bf16_t*)(F.ws + WS_SMP + SM_IQ); const float* IW = (const float*)(F.ws + WS_SMP + SM_IW);
    const float* CIK = (const float*)A.in[I_CIK]; const int* PT = (const int*)A.in[I_PT];
    float* SS = (float*)(F.ws + WS_SMP + SM_SCORE);
    const int s0 = c * 512 + wave * 64;
    const int page = PT[b * 128 + (s0 >> 7)];
    const float* kbase = CIK + ((size_t)page * 128 + (s0 & 127)) * 64;
    bf16x8 bk[2][4];
#pragma unroll
    for (int cb = 0; cb < 2; ++cb)
#pragma unroll
        for (int ks = 0; ks < 4; ++ks) { const GAS f32x4* p = (const GAS f32x4*)(kbase + (size_t)(cb * 32 + r32) * 64 + ks * 16 + 8 * hi); const f32x4 x = p[0], y = p[1];
            u32x4 w; w.x = pk2(x.x, x.y); w.y = pk2(x.z, x.w); w.z = pk2(y.x, y.y); w.w = pk2(y.z, y.w); bk[cb][ks] = __builtin_bit_cast(bf16x8, w); }
#pragma unroll
    for (int rb = 0; rb < 2; ++rb) {
        const bf16_t* ap = IQ + (size_t)(b * 4 + 2 * rb + (r32 >> 4)) * 1024 + (r32 & 15) * 64 + 8 * hi;
        f32x16 d0 = {}, d1 = {};
#pragma unroll
        for (int ks = 0; ks < 4; ++ks) { const bf16x8 a = *(const GAS bf16x8*)(ap + ks * 16);
            d0 = __builtin_amdgcn_mfma_f32_32x32x16_bf16(a, bk[0][ks], d0, 0, 0, 0); d1 = __builtin_amdgcn_mfma_f32_32x32x16_bf16(a, bk[1][ks], d1, 0, 0, 0); }
        float p00 = 0.f, p01 = 0.f, p10 = 0.f, p11 = 0.f;
#pragma unroll
        for (int r = 0; r < 16; ++r) { const int row = crow(r, hi), tl = row >> 4, h = row & 15; const float w = IW[(b * 4 + 2 * rb + tl) * 16 + h];
            const float e0 = fmaxf(d0[r], 0.f) * w, e1 = fmaxf(d1[r], 0.f) * w; if (r < 8) { p00 += e0; p10 += e1; } else { p01 += e0; p11 += e1; } }
        p00 += __shfl_xor(p00, 32); p01 += __shfl_xor(p01, 32); p10 += __shfl_xor(p10, 32); p11 += __shfl_xor(p11, 32);
        float* o = SS + (size_t)(b * 4 + 2 * rb + hi) * SLEN + s0 + r32;
        o[0] = hi ? p01 : p00; o[32] = hi ? p11 : p10;
    }
}
__device__ __forceinline__ void s1_tail(Frame& F, int b) {
    const int lane = F.lane; const bf16_t* IQ = (const bf16_t*)(F.ws + WS_SMP + SM_IQ); const bf16_t* IK = (const bf16_t*)(F.ws + WS_SMP + SM_IK);
    const float* IW = (const float*)(F.ws + WS_SMP + SM_IW); float* SS = (float*)(F.ws + WS_SMP + SM_SCORE);
    const int t = lane >> 4, tk = (lane >> 2) & 3, hq = lane & 3; float sc = 0.f;
    for (int hh = 0; hh < 4; ++hh) { const int h = hq * 4 + hh; float d = 0.f;
        for (int e = 0; e < 64; ++e) d += bf2f(IQ[(size_t)(b * 4 + t) * 1024 + h * 64 + e]) * bf2f(IK[(b * 4 + tk) * 64 + e]);
        sc += fmaxf(d, 0.f) * IW[(b * 4 + t) * 16 + h]; }
    sc += __shfl_xor(sc, 1); sc += __shfl_xor(sc, 2);
    if (hq == 0) SS[(size_t)(b * 4 + t) * SLEN + PAST + tk] = tk <= t ? sc : -INFINITY;
}
__device__ __forceinline__ unsigned fkey(float f) { const unsigned u = __builtin_bit_cast(unsigned, f); return (u & 0x80000000u) ? ~u : (u | 0x80000000u); }
__device__ __forceinline__ int wave_isum(int v) {
#pragma unroll
    for (int o = 1; o < 64; o <<= 1) v += __shfl_xor(v, o);
    return v;
}
__device__ __forceinline__ int popc64(u64 m) { return __builtin_popcountll(m); }
__device__ __forceinline__ int lane_rank(u64 m) { return (int)__builtin_amdgcn_mbcnt_hi((unsigned)(m >> 32), __builtin_amdgcn_mbcnt_lo((unsigned)m, 0u)); }

template <int I> struct D2Step {
    static __device__ __forceinline__ void run(const unsigned (&key)[64], unsigned tau, int need, int& taken, unsigned& wlo, unsigned& whi) {
        const bool gt = key[I] > tau, eq = key[I] == tau; const u64 em = __ballot(eq);
        const bool sel = gt || (eq && (taken + lane_rank(em) < need));
        taken += popc64(em);
        const u64 m = __ballot(sel); const unsigned mlo = (unsigned)m, mhi = (unsigned)(m >> 32);
        asm volatile("s_nop 3\n\tv_writelane_b32 %0, %1, %2" : "+v"(wlo) : "s"(mlo), "n"(I));
        asm volatile("s_nop 3\n\tv_writelane_b32 %0, %1, %2" : "+v"(whi) : "s"(mhi), "n"(I));
        D2Step<I + 1>::run(key, tau, need, taken, wlo, whi);
    }
};
template <> struct D2Step<64> { static __device__ __forceinline__ void run(const unsigned (&)[64], unsigned, int, int&, unsigned&, unsigned&) {} };

__device__ __forceinline__ int wave_isum_dpp(int v) {
    v += __builtin_amdgcn_update_dpp(0, v, 0xB1, 0xF, 0xF, true);
    v += __builtin_amdgcn_update_dpp(0, v, 0x4E, 0xF, 0xF, true);
    v += __builtin_amdgcn_update_dpp(0, v, 0x141, 0xF, 0xF, true);
    v += __builtin_amdgcn_update_dpp(0, v, 0x140, 0xF, 0xF, true);
    return __builtin_amdgcn_readlane(v, 0) + __builtin_amdgcn_readlane(v, 16) + __builtin_amdgcn_readlane(v, 32) + __builtin_amdgcn_readlane(v, 48);
}
__device__ __forceinline__ void d2_row(Frame& F, int row) {
    const int lane = F.lane, t = row & (SEQ - 1);
    const float* sc = (const float*)(F.ws + WS_SCORES) + (size_t)row * SEQ;
    u64* mo = (u64*)(F.ws + WS_MASK) + (size_t)row * 64;
    if (t < 256) {
        const int lo = lane * 64; const u64 myword = (t >= lo + 63) ? ~0ull : (t < lo ? 0ull : ((2ull << (t - lo)) - 1ull));
        mo[lane] = myword; return;
    }
    unsigned key[64];
    const int nfull = (t >> 6) + 1;
#pragma unroll
    for (int i = 0; i < 32; ++i) key[i] = __builtin_bit_cast(unsigned, sc[i * 64 + lane]);
#pragma unroll
    for (int i = 0; i < 32; ++i) asm volatile("" : "+v"(key[i]));
    if (nfull > 32) {
#pragma unroll
        for (int i = 32; i < 64; ++i) key[i] = __builtin_bit_cast(unsigned, sc[i * 64 + lane]);
#pragma unroll
        for (int i = 32; i < 64; ++i) asm volatile("" : "+v"(key[i]));
    } else {
#pragma unroll
        for (int i = 32; i < 64; ++i) key[i] = 0xff800000u;
    }
    unsigned lsb0 = 0u, lsb1 = 0u;
#pragma unroll
    for (int i = 0; i < 64; ++i) { const int s = i * 64 + lane; unsigned k = fkey(__builtin_bit_cast(float, key[i])); k = s <= t ? k : 0u;
        if (i < 32) lsb0 |= (k & 1u) << i; else lsb1 |= (k & 1u) << (i - 32); key[i] = k >> 1; }
    unsigned tau = 0u;
    for (int bit = 30; bit >= 0; --bit) {
        const unsigned cand = tau | (1u << bit); unsigned b0 = 0u, b1 = 0u;
#pragma unroll
        for (int i = 0; i < 32; ++i) { b0 = __builtin_amdgcn_alignbit(b0, key[i] - cand, 31); b1 = __builtin_amdgcn_alignbit(b1, key[i + 32] - cand, 31); }
        const int cnt = 4096 - wave_isum_dpp(__builtin_popcount(b0) + __builtin_popcount(b1));
        if (cnt >= 256) tau = cand;
        if (cnt == 256) break;
    }
#pragma unroll
    for (int i = 0; i < 64; ++i) key[i] = (key[i] << 1) | (((i < 32 ? lsb0 : lsb1) >> (i & 31)) & 1u);
    unsigned tau32 = tau << 1;
    { const unsigned c1 = tau32 | 1u; int c = 0;
#pragma unroll
      for (int i = 0; i < 64; ++i) c += (key[i] >= c1) ? 1 : 0;
      if (wave_isum_dpp(c) >= 256) tau32 = c1; }
    int cgt = 0;
    { int c = 0;
#pragma unroll
      for (int i = 0; i < 64; ++i) c += (key[i] > tau32) ? 1 : 0;
      cgt = wave_isum_dpp(c); }
    unsigned wlo = 0u, whi = 0u;
    const int need = 256 - cgt; int taken = 0;
    unsigned tau2 = tau32; asm volatile("" : "+v"(tau2));
    D2Step<0>::run(key, tau2, need, taken, wlo, whi);
    mo[lane] = ((u64)whi << 32) | wlo;
}

__device__ __forceinline__ void r2_scan(Frame& F) {
    const int gt = F.vcu * (NWAVES * 64) + F.tid;
    if (gt >= 131072) return;
    const int e = gt * 2, bh = e >> 14, off = e & 16383, h = bh & 7;
    const float cdec = exp2f(128.0f * lg2g(h));
    const float* kv = (const float*)(F.ws + WS_KVC) + (size_t)bh * 32 * 16384 + off;
    bf16_t* sp = (bf16_t*)(F.ws + WS_SPREV) + (size_t)bh * 32 * 16384 + off;
    float s0 = 0.f, s1 = 0.f; f32x2 k[32];
#pragma unroll
    for (int n = 0; n < 32; ++n) k[n] = *(const GAS f32x2*)(kv + (size_t)n * 16384);
#pragma unroll
    for (int n = 0; n < 32; ++n) {
        *(GAS unsigned*)(sp + (size_t)n * 16384) = pk2(s0, s1);
        s0 = cdec * (s0 + k[n].x); s1 = cdec * (s1 + k[n].y);
    }
    float* o = F.out + O_RSP + (size_t)bh * 16384; const int dv = off >> 7, dk = off & 127;
    o[dk * 128 + dv] = s0; o[(dk + 1) * 128 + dv] = s1;
}

__device__ __forceinline__ void s2_row(Frame& F, int q) {
    const int lane = F.lane, wave = F.wave, t = q & 3, n = PAST + t + 1;
    const float* sc = (const float*)(F.ws + WS_SMP + SM_SCORE) + (size_t)q * SLEN;
    int* so = (int*)(F.ws + WS_SMP + SM_SIDX) + q * 256;
    LAS int* cnts = (LAS int*)F.lds;
    unsigned key[33]; const int base = wave * 2112;
#pragma unroll
    for (int i = 0; i < 33; ++i) key[i] = __builtin_bit_cast(unsigned, sc[base + i * 64 + lane]);
#pragma unroll
    for (int i = 0; i < 33; ++i) asm volatile("" : "+v"(key[i]));
#pragma unroll
    for (int i = 0; i < 33; ++i) { const int s = base + i * 64 + lane; const unsigned k = fkey(__builtin_bit_cast(float, key[i])); key[i] = s < n ? k : 0u; }
    __syncthreads();
    unsigned tau = 0u;
    for (int bit = 31; bit >= 0; --bit) {
        const unsigned cand = tau | (1u << bit); int c = 0;
#pragma unroll
        for (int i = 0; i < 33; ++i) c += (key[i] >= cand) ? 1 : 0;
        const int cnt = wave_isum(c);
        LAS int* cb = cnts + (bit & 1) * 8;
        if (lane == 0) cb[wave] = cnt;
        __syncthreads();
        int tot = 0;
#pragma unroll
        for (int w = 0; w < 8; ++w) tot += cb[w];
        if (tot >= 256) tau = cand;
    }
    int cgt = 0, ceq = 0;
#pragma unroll
    for (int i = 0; i < 33; ++i) { cgt += (key[i] > tau) ? 1 : 0; ceq += (key[i] == tau) ? 1 : 0; }
    cgt = wave_isum(cgt); ceq = wave_isum(ceq);
    __syncthreads();
    if (lane == 0) { cnts[16 + wave] = cgt; cnts[32 + wave] = ceq; }
    __syncthreads();
    int gbase = 0, ebase = 0, gtot = 0;
#pragma unroll
    for (int w = 0; w < 8; ++w) { const int g = cnts[16 + w], e = cnts[32 + w]; if (w < wave) { gbase += g; ebase += e; } gtot += g; }
    const int need = 256 - gtot;
    int goff = gbase, eoff = ebase;
    unsigned tau2 = tau; asm volatile("" : "+v"(tau2));
#pragma unroll
    for (int i = 0; i < 33; ++i) {
        const int s = base + i * 64 + lane; const bool gt = key[i] > tau2, eq = key[i] == tau2;
        const u64 gm = __ballot(gt), em = __ballot(eq);
        if (gt) so[goff + lane_rank(gm)] = s;
        if (eq) { const int r = eoff + lane_rank(em); if (r < need) so[gtot + r] = s; }
        goff += popc64(gm); eoff += popc64(em);
        __builtin_amdgcn_sched_barrier(0);
    }
}
namespace fa {
constexpr int KVBLK = 64;
constexpr float SCALE = QK_SCALE;
constexpr size_t SHM_V = KVBLK * 128 * 2, SHM_K = KVBLK * 128 * 2;
constexpr int OFF_V = 0, OFF_K = 2 * SHM_V, OFF_WS = 2 * SHM_V + 2 * SHM_K;
#define KSWZ(row, colB) ((row) * 272 + (colB))
constexpr int KSLOT = 64 * 272;
#define SBAR() __builtin_amdgcn_sched_barrier(0)
__device__ __forceinline__ unsigned cvtpk(float lo, float hi) { unsigned r; asm volatile("v_cvt_pk_bf16_f32 %0, %1, %2" : "=v"(r) : "v"(lo), "v"(hi)); return r; }
__device__ __forceinline__ int v_st(int k, int c) { const int kk = (k & ~0xC) | ((k & 4) << 1) | ((k & 8) >> 1); return ((kk >> 3) * 4 + (c >> 5)) * 512 + ((kk & 7) * 32 + (c & 31)) * 2; }
__device__ __forceinline__ int v_rd_base(int lane) { return ((lane & 3) << 3) | (((lane >> 2) & 3) << 6) | (((lane >> 4) & 1) << 5) | (((lane >> 5) & 1) << 8); }
constexpr int v_rd_off(int d0, int ks, int half) { return d0 * 512 + ks * 4096 + half * 2048; }
template <int OFF> __device__ __forceinline__ s16x4 tr_read(int vb) { s16x4 r; asm volatile("ds_read_b64_tr_b16 %0, %1 offset:%2" : "=&v"(r) : "v"(vb), "i"(OFF) : "memory"); return r; }
template <int D0> __device__ __forceinline__ void pv_one(f32x16& od, int vb, bf16x8 pa0, bf16x8 pa1, bf16x8 pa2, bf16x8 pa3) {
#define PK(L, H) (bf16x8){L[0], L[1], L[2], L[3], H[0], H[1], H[2], H[3]}
    { const s16x4 l0 = tr_read<v_rd_off(D0, 0, 0)>(vb), h0 = tr_read<v_rd_off(D0, 0, 1)>(vb), l1 = tr_read<v_rd_off(D0, 1, 0)>(vb), h1 = tr_read<v_rd_off(D0, 1, 1)>(vb);
      asm volatile("s_waitcnt lgkmcnt(0)" ::: "memory"); SBAR();
      od = __builtin_amdgcn_mfma_f32_32x32x16_bf16(pa0, PK(l0, h0), od, 0, 0, 0);
      od = __builtin_amdgcn_mfma_f32_32x32x16_bf16(pa1, PK(l1, h1), od, 0, 0, 0); }
    { const s16x4 l2 = tr_read<v_rd_off(D0, 2, 0)>(vb), h2 = tr_read<v_rd_off(D0, 2, 1)>(vb), l3 = tr_read<v_rd_off(D0, 3, 0)>(vb), h3 = tr_read<v_rd_off(D0, 3, 1)>(vb);
      asm volatile("s_waitcnt lgkmcnt(0)" ::: "memory"); SBAR();
      od = __builtin_amdgcn_mfma_f32_32x32x16_bf16(pa2, PK(l2, h2), od, 0, 0, 0);
      od = __builtin_amdgcn_mfma_f32_32x32x16_bf16(pa3, PK(l3, h3), od, 0, 0, 0); }
#undef PK
}
__device__ __forceinline__ void pv_d0(f32x16* o, int vb, bf16x8 pa0, bf16x8 pa1, bf16x8 pa2, bf16x8 pa3) {
    pv_one<0>(o[0], vb, pa0, pa1, pa2, pa3); pv_one<1>(o[1], vb, pa0, pa1, pa2, pa3); pv_one<2>(o[2], vb, pa0, pa1, pa2, pa3); pv_one<3>(o[3], vb, pa0, pa1, pa2, pa3);
}
__device__ __forceinline__ void qkt(f32x16& p0, f32x16& p1, const LAS char* Ks, const bf16x8* qr, int r32, int hi) {
    p0 = f32x16{}; p1 = f32x16{};
#pragma unroll
    for (int d0 = 0; d0 < 8; ++d0) { const int cb = (d0 * 16 + hi * 8) * 2;
        const bf16x8 b0 = *(const LAS bf16x8*)(Ks + KSWZ(r32, cb)); const bf16x8 b1 = *(const LAS bf16x8*)(Ks + KSWZ(32 + r32, cb));
        p0 = __builtin_amdgcn_mfma_f32_32x32x16_bf16(b0, qr[d0], p0, 0, 0, 0); p1 = __builtin_amdgcn_mfma_f32_32x32x16_bf16(b1, qr[d0], p1, 0, 0, 0);
        if ((d0 & 1) == 1) SBAR(); }
}
constexpr float THR = 6.0f;
constexpr float CEXP = SCALE * 1.4426950408889634f;

constexpr int OFF_K3 = 0, OFF_V3 = 2 * KSLOT, OFF_WS3 = OFF_V3 + 3 * 16384, OFF_Q3 = OFF_WS3 + 2048, ATTN_LDS = OFF_Q3 + 8 * 32 * 272;
template <bool MASKED, bool QPART = false>
__device__ __forceinline__ void attn_wg(const void* qrow_, float qscale, const bf16_t* Kh, const bf16_t* Vh, int ldk, int nt, int ntw, const u64* mrow,
                                        bf16_t* orow0, int ldo, LAS char* lds, int tid) {
    const int wid = tid >> 6, lane = tid & 63, r32 = lane & 31, hi = lane >> 5;
    LAS char* K_lds = lds + OFF_K3; LAS char* V_lds = lds + OFF_V3;
    LAS float* wsf = (LAS float*)(lds + OFF_WS3) + wid * 64;
    float m_reg = -1e30f, l_reg = 0.f; f32x16 o[4] = {};
    const int vb0 = (int)(uintptr_t)V_lds + v_rd_base(lane);
    const int kfo = r32 * 272 + hi * 16;
    const LAS char* QB = lds + OFF_Q3 + wid * (32 * 272) + kfo;
    __syncthreads();
    if constexpr (!QPART) { const bf16_t* qrow = (const bf16_t*)qrow_;
#pragma unroll
        for (int d0 = 0; d0 < 8; ++d0) *(LAS bf16x8*)(QB + d0 * 32) = *(const GAS bf16x8*)(qrow + d0 * 16);
    } else {
        const float* qp = (const float*)qrow_;
#pragma unroll
        for (int d0 = 0; d0 < 8; ++d0) { f32x4 a = {0.f, 0.f, 0.f, 0.f}, c = {0.f, 0.f, 0.f, 0.f};
#pragma unroll
            for (int pk = 0; pk < 4; ++pk) { const GAS f32x4* p = (const GAS f32x4*)(qp + (size_t)pk * MP * MEMW + d0 * 16); a = a + p[0]; c = c + p[1]; }
            a = a * qscale; c = c * qscale; u32x4 w; w.x = cvtpk(a.x, a.y); w.y = cvtpk(a.z, a.w); w.z = cvtpk(c.x, c.y); w.w = cvtpk(c.z, c.w);
            *(LAS u32x4*)(QB + d0 * 32) = w; }
    }
    bf16x8 vs0, vs1, ks0, ks1;
#define SLOAD(k0) do { int t_ = tid; asm volatile("" : "+v"(t_)); const int sr = t_ >> 4, sc = (t_ & 15) * 8; const unsigned go_ = (unsigned)(((k0) + sr) * ldk + sc); \
    vs0 = *(const GAS bf16x8*)(Vh + go_); vs1 = *(const GAS bf16x8*)(Vh + go_ + 32 * ldk); ks0 = *(const GAS bf16x8*)(Kh + go_); ks1 = *(const GAS bf16x8*)(Kh + go_ + 32 * ldk); } while (0)
#define SWRITE(kb, vb) do { int t_ = tid; asm volatile("" : "+v"(t_)); const int sr = t_ >> 4, sc = (t_ & 15) * 8; \
    *(LAS bf16x8*)(V_lds + (vb) * 16384 + v_st(sr, sc)) = vs0; *(LAS bf16x8*)(V_lds + (vb) * 16384 + v_st(32 + sr, sc)) = vs1; const int kc = sc * 2; \
    *(LAS bf16x8*)(K_lds + (kb) * KSLOT + KSWZ(sr, kc)) = ks0; *(LAS bf16x8*)(K_lds + (kb) * KSLOT + KSWZ(32 + sr, kc)) = ks1; } while (0)
    f32x16 pA0, pA1, pB0, pB1; float alA = 1.f, alB = 1.f; bf16x8 pa0, pa1, pa2, pa3;
#define QKG(g, PN0, PN1) do { const LAS char* kp_ = KB + kfo + (g) * 64; \
        const bf16x8 a0_ = *(const LAS bf16x8*)(kp_), a1_ = *(const LAS bf16x8*)(kp_ + 32 * 272), c0_ = *(const LAS bf16x8*)(kp_ + 32), c1_ = *(const LAS bf16x8*)(kp_ + 32 * 272 + 32); \
        const bf16x8 q0_ = *(const LAS bf16x8*)(QB + (g) * 64), q1_ = *(const LAS bf16x8*)(QB + (g) * 64 + 32); \
        PN0 = __builtin_amdgcn_mfma_f32_32x32x16_bf16(a0_, q0_, PN0, 0, 0, 0); PN1 = __builtin_amdgcn_mfma_f32_32x32x16_bf16(a1_, q0_, PN1, 0, 0, 0); \
        PN0 = __builtin_amdgcn_mfma_f32_32x32x16_bf16(c0_, q1_, PN0, 0, 0, 0); PN1 = __builtin_amdgcn_mfma_f32_32x32x16_bf16(c1_, q1_, PN1, 0, 0, 0); } while (0)
#define FINC(P, BASE, OUT) do { _Pragma("unroll") for (int r_ = (BASE); r_ < (BASE) + 8; ++r_) { P[r_] = __builtin_amdgcn_exp2f(fmaf(P[r_], CEXP, mnC)); ps += P[r_]; } \
        unsigned a0_ = cvtpk(P[BASE + 0], P[BASE + 1]), a1_ = cvtpk(P[BASE + 2], P[BASE + 3]), b0_ = cvtpk(P[BASE + 4], P[BASE + 5]), b1_ = cvtpk(P[BASE + 6], P[BASE + 7]); \
        auto r0_ = __builtin_amdgcn_permlane32_swap(a0_, b0_, false, false); auto r1_ = __builtin_amdgcn_permlane32_swap(a1_, b1_, false, false); \
        u32x4 w_ = {r0_[0], r1_[0], r0_[1], r1_[1]}; OUT = __builtin_bit_cast(bf16x8, w_); } while (0)
#define MAXC(P, BASE) do { _Pragma("unroll") for (int r_ = (BASE); r_ < (BASE) + 8; ++r_) pmax = fmaxf(pmax, P[r_]); } while (0)
#define PINIT(PN0, PN1, MW) do { if (MASKED) { const unsigned lo_ = (unsigned)(MW) >> (4 * hi), hh_ = (unsigned)((MW) >> 32) >> (4 * hi); \
        _Pragma("unroll") for (int r_ = 0; r_ < 16; ++r_) { const int bit_ = (r_ & 3) + 8 * (r_ >> 2); PN0[r_] = ((lo_ >> bit_) & 1u) ? 0.f : -3.0e38f; PN1[r_] = ((hh_ >> bit_) & 1u) ? 0.f : -3.0e38f; } } \
        else { PN0 = f32x16{}; PN1 = f32x16{}; } } while (0)
#define DECIDE(AN) do { { auto rr_ = __builtin_amdgcn_permlane32_swap(__float_as_uint(pmax), __float_as_uint(pmax), false, false); pmax = fmaxf(__uint_as_float(rr_[0]), __uint_as_float(rr_[1])); } \
        AN = 1.f; if (!__all(pmax - m_reg <= THR / SCALE)) { const float mn_ = fmaxf(m_reg, pmax); AN = __builtin_amdgcn_exp2f((m_reg - mn_) * CEXP); m_reg = mn_; } } while (0)
#define MIDSTEP(j, PN0, PN1, AN, PO0, PO1, AO) do { const int j_ = (j); \
        if (j_ + 1 < nt) { SWRITE((j_ + 1) & 1, vnext); } \
        if (j_ <= ntw) { \
            u64 mw = 0; if (MASKED) { int l_ = lane; asm volatile("" : "+v"(l_)); mw = mrow[(l_ & 31) * 64 + (j_ < 63 ? j_ : 63)]; } \
            const LAS char* KB = K_lds + (j_ & 1) * KSLOT; const float mnC = -m_reg * CEXP; float ps = 0.f; \
            PINIT(PN0, PN1, mw); \
            SBAR(); QKG(0, PN0, PN1); FINC(PO0, 0, pa0); SBAR(); QKG(1, PN0, PN1); FINC(PO0, 8, pa1); SBAR(); \
            if (j_ + 2 < nt) SLOAD((j_ + 2) * KVBLK);        \
            QKG(2, PN0, PN1); FINC(PO1, 0, pa2); SBAR(); QKG(3, PN0, PN1); FINC(PO1, 8, pa3); SBAR(); \
            { auto rr_ = __builtin_amdgcn_permlane32_swap(__float_as_uint(ps), __float_as_uint(ps), false, false); ps = __uint_as_float(rr_[0]) + __uint_as_float(rr_[1]); } \
            l_reg = l_reg * AO + ps; \
            if (__any(AO < 1.f)) { if (hi == 0) wsf[r32] = AO; asm volatile("s_waitcnt lgkmcnt(0)" ::: "memory"); \
                _Pragma("unroll") for (int d = 0; d < 4; ++d) _Pragma("unroll") for (int r = 0; r < 16; ++r) o[d][r] *= wsf[crow(r, hi)]; } \
            float pmax = -3.0e38f; const int vb_ = vb0 + vprev * 16384; \
            SBAR(); pv_one<0>(o[0], vb_, pa0, pa1, pa2, pa3); MAXC(PN0, 0); SBAR(); pv_one<1>(o[1], vb_, pa0, pa1, pa2, pa3); MAXC(PN0, 8); SBAR(); \
            pv_one<2>(o[2], vb_, pa0, pa1, pa2, pa3); MAXC(PN1, 0); SBAR(); pv_one<3>(o[3], vb_, pa0, pa1, pa2, pa3); MAXC(PN1, 8); SBAR(); \
            DECIDE(AN); \
        } \
        __syncthreads(); \
        vprev = vcur; vcur = vnext; vnext = (vnext == 2) ? 0 : vnext + 1; } while (0)
    __syncthreads();
    SLOAD(0); SWRITE(0, 0); if (nt > 1) SLOAD(KVBLK);
    __syncthreads();
    {
        if (nt > 1) { SWRITE(1, 1); } if (nt > 2) SLOAD(2 * KVBLK);
        u64 mw = 0; if (MASKED) { int l_ = lane; asm volatile("" : "+v"(l_)); mw = mrow[(l_ & 31) * 64]; }
        const LAS char* KB = K_lds; PINIT(pA0, pA1, mw);
        QKG(0, pA0, pA1); QKG(1, pA0, pA1); QKG(2, pA0, pA1); QKG(3, pA0, pA1);
        float pmax = -3.0e38f;
        MAXC(pA0, 0); MAXC(pA0, 8); MAXC(pA1, 0); MAXC(pA1, 8); DECIDE(alA);
        __syncthreads();
    }
    int vprev = 0, vcur = 1, vnext = 2;
    for (int j = 1; j <= nt; j += 2) {
        MIDSTEP(j, pB0, pB1, alB, pA0, pA1, alA);
        if (j + 1 <= nt) MIDSTEP(j + 1, pA0, pA1, alA, pB0, pB1, alB);
    }
    if (hi == 0) wsf[32 + r32] = l_reg; asm volatile("s_waitcnt lgkmcnt(0)" ::: "memory");
    if (ntw > 0) {
#pragma unroll
        for (int r = 0; r < 16; ++r) { const int orow = crow(r, hi); const float rl = __builtin_amdgcn_rcpf(wsf[32 + orow]);
#pragma unroll
            for (int d0 = 0; d0 < 4; ++d0) *(GAS bf16_t*)(orow0 + (size_t)orow * ldo + d0 * 32 + r32) = (bf16_t)f2bf(o[d0][r] * rl); }
    }
#undef MIDSTEP
#undef DECIDE
#undef MAXC
#undef PINIT
#undef FINC
#undef QKG
#undef SLOAD
#undef SWRITE
}
}
__device__ __forceinline__ void d3_unit(Frame& F, int b, int g, int qb) {
    const int lane = F.lane, wave = F.wave, r32 = lane & 31, hi = lane >> 5;
    const int head = 4 * g + (wave >> 1), nt = qb + 1;
    const size_t row0 = (size_t)b * SEQ + qb * 64 + (wave & 1) * 32;
    const bf16_t* qrow = (const bf16_t*)(F.ws + WS_DQ) + (row0 + r32) * 1024 + head * 128 + hi * 8;
    const bf16_t* Kh = (const bf16_t*)(F.ws + WS_DK) + (size_t)b * SEQ * 256 + g * 128; const bf16_t* Vh = (const bf16_t*)(F.ws + WS_DV) + (size_t)b * SEQ * 256 + g * 128;
    const u64* mrow = (const u64*)(F.ws + WS_MASK) + row0 * 64;
    bf16_t* orow0 = (bf16_t*)(F.ws + WS_DSAO) + row0 * 1024 + head * 128;
    fa::attn_wg<true>(qrow, 1.f, Kh, Vh, 256, nt, nt, mrow, orow0, 1024, (LAS char*)F.lds, F.tid);
}
__device__ __forceinline__ void xattn_unit(Frame& F, int b, int h, int qb) {
    const int lane = F.lane, wave = F.wave, r32 = lane & 31, hi = lane >> 5;
    const size_t row0 = (size_t)b * SEQ + qb * 256 + wave * 32;
    const float* qrow = (const float*)(F.ws + WS_QMP) + (row0 + r32) * 512 + h * 128 + hi * 8;
    const float rs = 1.0f / sqrtf(((const float*)(F.ws + WS_SSQ))[row0 + r32] * (1.0f / DM) + EPS);
    const bf16_t* Kh = (const bf16_t*)(F.ws + WS_MEMKB) + (size_t)b * 256 * 512 + h * 128; const bf16_t* Vh = (const bf16_t*)(F.ws + WS_MEMVB) + (size_t)b * 256 * 512 + h * 128;
    bf16_t* orow0 = (bf16_t*)(F.ws + WS_OM) + row0 * 512 + h * 128;
    fa::attn_wg<false, true>(qrow, rs, Kh, Vh, 512, 4, 4, nullptr, orow0, 512, (LAS char*)F.lds, F.tid);
}

__device__ __forceinline__ float half_sum32(float v) {
    v += __builtin_bit_cast(float, __builtin_amdgcn_update_dpp(0, __builtin_bit_cast(int, v), 0xB1, 0xF, 0xF, true));
    v += __builtin_bit_cast(float, __builtin_amdgcn_update_dpp(0, __builtin_bit_cast(int, v), 0x4E, 0xF, 0xF, true));
    v += __builtin_bit_cast(float, __builtin_amdgcn_update_dpp(0, __builtin_bit_cast(int, v), 0x141, 0xF, 0xF, true));
    v += __builtin_bit_cast(float, __builtin_amdgcn_update_dpp(0, __builtin_bit_cast(int, v), 0x140, 0xF, 0xF, true));
    return v + __shfl_xor(v, 16);
}
__device__ __forceinline__ void r3_unit(Frame& F, const Args& A, int b, int n, int hp) {
    int lane = F.lane; asm volatile("" : "+v"(lane));
    const int wave = F.wave, r32 = lane & 31, hi = lane >> 5, tb = wave & 3, hl = wave >> 2, head = 2 * hp + hl, tid_ = wave * 64 + lane;
    LAS bf16_t* Vt = (LAS bf16_t*)F.lds + hl * (128 * TLD);
    const size_t row0 = (size_t)b * SEQ + n * 128;
    const bf16_t* RQ = (const bf16_t*)(F.ws + WS_RQ); const bf16_t* RK = (const bf16_t*)(F.ws + WS_RK); const bf16_t* RV = (const bf16_t*)(F.ws + WS_RV);
    __syncthreads();
    stage_tile128(RV + row0 * 1024 + (2 * hp) * 128, 1024, (LAS bf16_t*)F.lds, tid_);
    stage_tile128(RV + row0 * 1024 + (2 * hp + 1) * 128, 1024, (LAS bf16_t*)F.lds + 128 * TLD, tid_);
    bf16x8 qf[8];
#pragma unroll
    for (int ks = 0; ks < 8; ++ks) qf[ks] = *(const GAS bf16x8*)(RQ + (row0 + 32 * tb + r32) * 1024 + head * 128 + 16 * ks + 8 * hi);
    f32x16 o[4] = {};
    {
        const bf16_t* SP = (const bf16_t*)(F.ws + WS_SPREV) + ((size_t)(b * 8 + head) * 32 + n) * 16384;
#pragma unroll
        for (int d = 0; d < 4; ++d) { bf16x8 sf[8];
#pragma unroll
            for (int ks = 0; ks < 8; ++ks) sf[ks] = *(const GAS bf16x8*)(SP + (32 * d + r32) * 128 + 16 * ks + 8 * hi);
#pragma unroll
            for (int ks = 0; ks < 8; ++ks) o[d] = __builtin_amdgcn_mfma_f32_32x32x16_bf16(qf[ks], sf[ks], o[d], 0, 0, 0); }
    }
    bf16x8 kf[8];
#pragma unroll
    for (int ks = 0; ks < 8; ++ks) kf[ks] = *(const GAS bf16x8*)(RK + (row0 + r32) * 1024 + head * 128 + 16 * ks + 8 * hi);
    __syncthreads();
    for (int jb = 0; jb <= tb; ++jb) {
        f32x16 st = {};
#pragma unroll
        for (int ks = 0; ks < 8; ++ks) st = __builtin_amdgcn_mfma_f32_32x32x16_bf16(kf[ks], qf[ks], st, 0, 0, 0);
        if (jb < tb) {
#pragma unroll
            for (int ks = 0; ks < 8; ++ks) kf[ks] = *(const GAS bf16x8*)(RK + (row0 + 32 * (jb + 1) + r32) * 1024 + head * 128 + 16 * ks + 8 * hi);
        }
        if (jb == tb) {
#pragma unroll
            for (int r = 0; r < 16; ++r) if (crow(r, hi) > r32) st[r] = 0.f;
        }
        bf16x8 pa0, pa1;
#define PK4(P, BASE, OUT) do { unsigned a0 = fa::cvtpk(P[BASE + 0], P[BASE + 1]), a1 = fa::cvtpk(P[BASE + 2], P[BASE + 3]);   \
    unsigned b0 = fa::cvtpk(P[BASE + 4], P[BASE + 5]), b1 = fa::cvtpk(P[BASE + 6], P[BASE + 7]);                              \
    auto r0 = __builtin_amdgcn_permlane32_swap(a0, b0, false, false); auto r1 = __builtin_amdgcn_permlane32_swap(a1, b1, false, false); \
    u32x4 w = {r0[0], r1[0], r0[1], r1[1]}; OUT = __builtin_bit_cast(bf16x8, w); } while (0)
        PK4(st, 0, pa0); PK4(st, 8, pa1);
#undef PK4
#pragma unroll
        for (int d = 0; d < 4; ++d) { const bf16x8 v0 = tr_frag(Vt, TLD, 32 * jb, 32 * d, lane), v1 = tr_frag(Vt, TLD, 32 * jb + 16, 32 * d, lane);
            o[d] = __builtin_amdgcn_mfma_f32_32x32x16_bf16(pa0, v0, o[d], 0, 0, 0); o[d] = __builtin_amdgcn_mfma_f32_32x32x16_bf16(pa1, v1, o[d], 0, 0, 0); }
    }
    const float* gn = (const float*)A.in[I_GNRET] + head * 128; const bf16_t* RG = (const bf16_t*)(F.ws + WS_RG); bf16_t* RY = (bf16_t*)(F.ws + WS_RETY);
    float gnv[4];
#pragma unroll
    for (int d = 0; d < 4; ++d) gnv[d] = gn[32 * d + r32];
    const size_t rb = (row0 + 32 * tb) * 1024 + head * 128 + r32;
    unsigned short sg[16][4];
#pragma unroll
    for (int r = 0; r < 16; ++r)
#pragma unroll
        for (int d = 0; d < 4; ++d) sg[r][d] = *(const GAS bf16_t*)(RG + rb + (size_t)crow(r, hi) * 1024 + 32 * d);
#pragma unroll
    for (int r = 0; r < 16; ++r) {
        const float s1 = half_sum32((o[0][r] + o[1][r]) + (o[2][r] + o[3][r]));
        const float mu = s1 * (1.0f / 128.0f);
        float s2 = 0.f;
#pragma unroll
        for (int d = 0; d < 4; ++d) { const float c = o[d][r] - mu; s2 += c * c; }
        s2 = half_sum32(s2);
        const float rs = 1.0f / sqrtf(s2 * (1.0f / 128.0f) + EPS);
#pragma unroll
        for (int d = 0; d < 4; ++d) *(GAS bf16_t*)(RY + rb + (size_t)crow(r, hi) * 1024 + 32 * d) = (bf16_t)f2bf((o[d][r] - mu) * rs * gnv[d] * bf2f(sg[r][d]));
    }
}

__device__ __forceinline__ void s3_ret_unit(Frame& F, const Args& A, int bh) {
    int tid = F.tid; asm volatile("" : "+v"(tid));
    const int b = bh >> 3, h = bh & 7, dv = tid & 127, sl = tid >> 7;
    LAS float* qs = (LAS float*)F.lds;
    LAS float* ks = qs + 512;
    LAS float* vs = ks + 512;
    LAS float* oc = vs + 512;
    LAS float* st = oc + 2048;
    LAS float* red = st + 16;
    const bf16_t* RQ = (const bf16_t*)(F.ws + WS_SMP + SM_RQ); const bf16_t* RK = (const bf16_t*)(F.ws + WS_SMP + SM_RK); const bf16_t* RV = (const bf16_t*)(F.ws + WS_SMP + SM_RV);
    __syncthreads();
    { const int t = tid >> 7, d = tid & 127; const size_t o = (size_t)(b * 4 + t) * 1024 + h * 128 + d; qs[tid] = bf2f(RQ[o]); ks[tid] = bf2f(RK[o]); vs[tid] = bf2f(RV[o]); }
    __syncthreads();
    if (tid < 16) { const int t = tid >> 2, j = tid & 3; float s = 0.f; for (int d = 0; d < 128; ++d) s += qs[t * 128 + d] * ks[j * 128 + d]; st[tid] = j <= t ? s : 0.f; }
    const float* S0 = (const float*)A.in[I_STATE] + (size_t)bh * 16384; float* SO = F.out + O_RSS + (size_t)bh * 16384;
    const float g4 = exp2f(4.0f * lg2g(h));
    const float v0 = vs[dv], v1 = vs[128 + dv], v2 = vs[256 + dv], v3 = vs[384 + dv];
    float c0 = 0.f, c1 = 0.f, c2 = 0.f, c3 = 0.f;
#pragma unroll 16
    for (int i = 0; i < 32; ++i) { const int dk = sl * 32 + i; const float s0 = S0[dk * 128 + dv];
        c0 += qs[dk] * s0; c1 += qs[128 + dk] * s0; c2 += qs[256 + dk] * s0; c3 += qs[384 + dk] * s0;
        SO[dk * 128 + dv] = g4 * (s0 + ks[dk] * v0 + ks[128 + dk] * v1 + ks[256 + dk] * v2 + ks[384 + dk] * v3); }
    oc[(sl * 4 + 0) * 128 + dv] = c0; oc[(sl * 4 + 1) * 128 + dv] = c1; oc[(sl * 4 + 2) * 128 + dv] = c2; oc[(sl * 4 + 3) * 128 + dv] = c3;
    __syncthreads();
    const int t = sl; float o = oc[(0 * 4 + t) * 128 + dv] + oc[(1 * 4 + t) * 128 + dv] + oc[(2 * 4 + t) * 128 + dv] + oc[(3 * 4 + t) * 128 + dv];
    o += st[t * 4 + 0] * v0 + st[t * 4 + 1] * v1 + st[t * 4 + 2] * v2 + st[t * 4 + 3] * v3;
    const float ws1 = wave_sum(o); if (F.lane == 0) red[t * 4 + (F.wave & 1)] = ws1;
    __syncthreads();
    const float mu = (red[t * 4 + 0] + red[t * 4 + 1]) * (1.0f / 128.0f); const float c = o - mu;
    const float ws2 = wave_sum(c * c); if (F.lane == 0) red[t * 4 + 2 + (F.wave & 1)] = ws2;
    __syncthreads();
    const float rs = 1.0f / sqrtf((red[t * 4 + 2] + red[t * 4 + 3]) * (1.0f / 128.0f) + EPS);
    const size_t ro = (size_t)(b * 4 + t) * 1024 + h * 128 + dv;
    const float sg = bf2f(((const bf16_t*)(F.ws + WS_SMP + SM_RG))[ro]);
    ((bf16_t*)(F.ws + WS_SMP + SM_RETY))[ro] = (bf16_t)f2bf(c * rs * ((const float*)A.in[I_GNRET])[h * 128 + dv] * sg);
}

template <typename T> struct Ld8;
template <> struct Ld8<float> { typedef struct { f32x4 a, b; } R; static __device__ __forceinline__ R ld(const float* p) { R r; r.a = *(const GAS f32x4*)p; r.b = *(const GAS f32x4*)(p + 4); return r; }
    static __device__ __forceinline__ void cvt(const R& r, float (&x)[8]) { x[0] = r.a.x; x[1] = r.a.y; x[2] = r.a.z; x[3] = r.a.w; x[4] = r.b.x; x[5] = r.b.y; x[6] = r.b.z; x[7] = r.b.w; } };
template <> struct Ld8<bf16_t> { typedef u32x4 R; static __device__ __forceinline__ R ld(const bf16_t* p) { return *(const GAS u32x4*)p; }
    static __device__ __forceinline__ void cvt(const R& r, float (&x)[8]) { x[0] = bflo(r.x); x[1] = bfhi(r.x); x[2] = bflo(r.y); x[3] = bfhi(r.y); x[4] = bflo(r.z); x[5] = bfhi(r.z); x[6] = bflo(r.w); x[7] = bfhi(r.w); } };
template <typename T, class KP, class VP>
__device__ __forceinline__ void wave_attn256(const LAS float* qv, LAS float* lg, KP kp, VP vp, int lane, float (&out)[8]) {
    const int sub = lane & 15, kq = lane >> 4; float q8[8];
#pragma unroll
    for (int e = 0; e < 8; ++e) q8[e] = qv[8 * sub + e];
    for (int it0 = 0; it0 < 64; it0 += 16) {
        typename Ld8<T>::R raw[16];
#pragma unroll
        for (int u = 0; u < 16; ++u) raw[u] = Ld8<T>::ld(kp(4 * (it0 + u) + kq) + 8 * sub);
#pragma unroll
        for (int u = 0; u < 16; ++u) { float x[8]; Ld8<T>::cvt(raw[u], x); float d = 0.f;
#pragma unroll
            for (int e = 0; e < 8; ++e) d += q8[e] * x[e];
            d = sum16(d); if (sub == 0) lg[4 * (it0 + u) + kq] = d; }
    }
    LDS_WAIT();
    float l0 = lg[lane], l1 = lg[64 + lane], l2 = lg[128 + lane], l3 = lg[192 + lane];
    const float mx = wave_max(fmaxf(fmaxf(l0, l1), fmaxf(l2, l3)));
    l0 = __expf(l0 - mx); l1 = __expf(l1 - mx); l2 = __expf(l2 - mx); l3 = __expf(l3 - mx);
    const float inv = 1.0f / wave_sum((l0 + l1) + (l2 + l3));
    lg[lane] = l0 * inv; lg[64 + lane] = l1 * inv; lg[128 + lane] = l2 * inv; lg[192 + lane] = l3 * inv;
    LDS_WAIT();
    float acc[8] = {0.f, 0.f, 0.f, 0.f, 0.f, 0.f, 0.f, 0.f};
    for (int it0 = 0; it0 < 64; it0 += 16) {
        typename Ld8<T>::R raw[16];
#pragma unroll
        for (int u = 0; u < 16; ++u) raw[u] = Ld8<T>::ld(vp(4 * (it0 + u) + kq) + 8 * sub);
#pragma unroll
        for (int u = 0; u < 16; ++u) { float x[8]; Ld8<T>::cvt(raw[u], x); const float pr = lg[4 * (it0 + u) + kq];
#pragma unroll
            for (int e = 0; e < 8; ++e) acc[e] += pr * x[e]; }
    }
#pragma unroll
    for (int e = 0; e < 8; ++e) { float v = acc[e]; v += __shfl_xor(v, 16); v += __shfl_xor(v, 32); out[e] = v; }
}
__device__ __forceinline__ void s3_attn_unit(Frame& F, const Args& A, int q) {
    int lane = F.lane; asm volatile("" : "+v"(lane));
    const int wave = F.wave, tid = wave * 64 + lane, b = q >> 2, g = wave >> 2;
    LAS int* koff = (LAS int*)F.lds;
    LAS float* qv = (LAS float*)(F.lds + 1024) + wave * 128; LAS float* lg = (LAS float*)(F.lds + 1024 + 4096) + wave * 256;
    const int* sidx = (const int*)(F.ws + WS_SMP + SM_SIDX) + q * 256; const int* PT = (const int*)A.in[I_PT];
    __syncthreads();
    if (tid < 256) { const int s = sidx[tid]; int v; if (s < PAST) v = (PT[b * 128 + (s >> 7)] * 128 + (s & 127)); else v = -(1 + (b * 4 + (s - PAST))); koff[tid] = v; }
    { const bf16_t* dq = (const bf16_t*)(F.ws + WS_SMP + SM_DQ) + (size_t)q * 1024 + wave * 128; qv[lane] = bf2f(dq[lane]) * QK_SCALE; qv[64 + lane] = bf2f(dq[64 + lane]) * QK_SCALE; }
    __syncthreads();
    const float* CK = (const float*)A.in[I_CK]; const float* CV = (const float*)A.in[I_CV]; const float* NK = F.out + O_KS; const float* NV = F.out + O_VS;
    auto kp = [&](int key) -> const float* { const int v = koff[key]; return v >= 0 ? CK + (size_t)v * 256 + g * 128 : NK + (size_t)(-1 - v) * 256 + g * 128; };
    auto vp = [&](int key) -> const float* { const int v = koff[key]; return v >= 0 ? CV + (size_t)v * 256 + g * 128 : NV + (size_t)(-1 - v) * 256 + g * 128; };
    float o[8]; wave_attn256<float>(qv, lg, kp, vp, lane, o);
    if (lane < 16) { u32x4 w; w.x = pk2(o[0], o[1]); w.y = pk2(o[2], o[3]); w.z = pk2(o[4], o[5]); w.w = pk2(o[6], o[7]);
        *(GAS u32x4*)((bf16_t*)(F.ws + WS_SMP + SM_DSAO) + (size_t)q * 1024 + wave * 128 + 8 * lane) = w; }
}
__device__ __forceinline__ void s7_xattn_unit(Frame& F, int b) {
    const int lane = F.lane, wave = F.wave;
    LAS float* qv = (LAS float*)(F.lds) + wave * 128; LAS float* lg = (LAS float*)(F.lds + 4096) + wave * 256;
    const bf16_t* MK = (const bf16_t*)(F.ws + WS_MEMKB) + (size_t)(2 + b) * 256 * 512; const bf16_t* MV = (const bf16_t*)(F.ws + WS_MEMVB) + (size_t)(2 + b) * 256 * 512;
    __syncthreads();
    for (int c = 0; c < 2; ++c) { const int th = wave * 2 + c, t = th >> 2, h = th & 3, q = b * 4 + t;
        const bf16_t* qm = (const bf16_t*)(F.ws + WS_SMP + SM_QM) + (size_t)q * 512 + h * 128;
        LDS_WAIT(); qv[lane] = bf2f(qm[lane]) * QK_SCALE; qv[64 + lane] = bf2f(qm[64 + lane]) * QK_SCALE; LDS_WAIT();
        auto kp = [&](int key) -> const bf16_t* { return MK + (size_t)key * 512 + h * 128; };
        auto vp = [&](int key) -> const bf16_t* { return MV + (size_t)key * 512 + h * 128; };
        float o[8]; wave_attn256<bf16_t>(qv, lg, kp, vp, lane, o);
        if (lane < 16) { u32x4 w; w.x = pk2(o[0], o[1]); w.y = pk2(o[2], o[3]); w.z = pk2(o[4], o[5]); w.w = pk2(o[6], o[7]);
            *(GAS u32x4*)((bf16_t*)(F.ws + WS_SMP + SM_OM) + (size_t)q * 512 + h * 128 + 8 * lane) = w; } }
}
__device__ __forceinline__ f32x4 ld_bf4(const bf16_t* p) { const u32x2 w = *(const GAS u32x2*)p; return (f32x4){bflo(w.x), bfhi(w.x), bflo(w.y), bfhi(w.y)}; }
__device__ __forceinline__ float rowsq64(const f32x4& a, const f32x4& b, const f32x4& c, const f32x4& d) {
    float s = (a.x * a.x + a.y * a.y) + (a.z * a.z + a.w * a.w) + (b.x * b.x + b.y * b.y) + (b.z * b.z + b.w * b.w)
            + (c.x * c.x + c.y * c.y) + (c.z * c.z + c.w * c.w) + (d.x * d.x + d.y * d.y) + (d.z * d.z + d.w * d.w);
    s += __shfl_xor(s, 16); s += __shfl_xor(s, 32); return s;
}
__device__ __forceinline__ float rstd32(const float* ssq, int row) { return 1.0f / sqrtf(ssq[row] * (1.0f / DM) + EPS); }
struct EpiMerge {
    static constexpr bool PERM = false, AFTER_DRAIN = false, KEEP = true;
    const bf16_t* GA; const bf16_t* GB; bf16_t* MG;
    __device__ __forceinline__ bool keep(const pg8::Unit& u) const { return u.pm >= 32; }
    __device__ __forceinline__ void operator()(f32x4 (&acc)[2][2][4][2], const pg8::Unit& u, int wr, int wc, int fr, int fq) const {
        const bool first = u.pm >= 32; const int pm = first ? u.pm - 32 : u.pm, pn = first ? u.pn - 8 : u.pn;
        const int rowb = pm * 256 + wr * 64 + fr, cb = pn * 256 + 32 * wc + 4 * fq;
#pragma unroll
        for (int ai = 0; ai < 2; ++ai)
#pragma unroll
            for (int m = 0; m < 4; ++m) { const size_t ro = (size_t)(rowb + ai * 128 + m * 16) * DM + cb;
#pragma unroll
                for (int bj = 0; bj < 2; ++bj)
#pragma unroll
                    for (int n = 0; n < 2; ++n) { const size_t off = ro + bj * 128 + 16 * n; f32x4 ga = ld_bf4(GA + off);
                        if (first) { const f32x4 gb = ld_bf4(GB + off); ga.x = fmaxf(ga.x, 1e-20f); ga.y = fmaxf(ga.y, 1e-20f); ga.z = fmaxf(ga.z, 1e-20f); ga.w = fmaxf(ga.w, 1e-20f);
                            f32x4 q; q.x = gb.x / ga.x; q.y = gb.y / ga.y; q.z = gb.z / ga.z; q.w = gb.w / ga.w; acc[ai][bj][m][n] = acc[ai][bj][m][n] * q; }
                        else { ga.x = fmaxf(ga.x, 1e-20f); ga.y = fmaxf(ga.y, 1e-20f); ga.z = fmaxf(ga.z, 1e-20f); ga.w = fmaxf(ga.w, 1e-20f); st_bf4(MG + off, acc[ai][bj][m][n] * ga); } }
                asm volatile("" ::: "memory"); }
    }
};
struct EpiResid {
    static constexpr bool PERM = false, AFTER_DRAIN = false, KEEP = false;
    const float* R; float* H; bf16_t* HB; float* SSQ;
    __device__ __forceinline__ void operator()(const f32x4 (&acc)[2][2][4][2], const pg8::Unit& u, int wr, int wc, int fr, int fq) const {
        const int rowb = u.pm * 256 + wr * 64 + fr, cb = u.pn * 256 + 32 * wc + 4 * fq;
#pragma unroll
        for (int ai = 0; ai < 2; ++ai)
#pragma unroll
            for (int m = 0; m < 4; ++m) { const int row = rowb + ai * 128 + m * 16; const size_t ro = (size_t)row * DM + cb; f32x4 v[2][2];
#pragma unroll
                for (int bj = 0; bj < 2; ++bj)
#pragma unroll
                    for (int n = 0; n < 2; ++n) { const size_t off = ro + bj * 128 + 16 * n; v[bj][n] = *(const GAS f32x4*)(R + off) + acc[ai][bj][m][n];
                        *(GAS f32x4*)(H + off) = v[bj][n]; if (HB) st_bf4(HB + off, v[bj][n]); }
                const float s = rowsq64(v[0][0], v[0][1], v[1][0], v[1][1]);
                if (fq == 0) atomicAdd(SSQ + row, s); }
    }
};
struct EpiQmPart {
    static constexpr bool PERM = false, AFTER_DRAIN = false, KEEP = false;
    float* QMP;
    __device__ __forceinline__ void operator()(const f32x4 (&acc)[2][2][4][2], const pg8::Unit& u, int wr, int wc, int fr, int fq) const {
        const int rowb = u.pm * 256 + wr * 64 + fr, cb = u.pn * 256 + 32 * wc + 4 * fq; float* base = QMP + (size_t)u.pk * MP * MEMW;
#pragma unroll
        for (int ai = 0; ai < 2; ++ai)
#pragma unroll
            for (int m = 0; m < 4; ++m) { const int row = rowb + ai * 128 + m * 16;
#pragma unroll
                for (int bj = 0; bj < 2; ++bj)
#pragma unroll
                    for (int n = 0; n < 2; ++n) *(GAS f32x4*)(base + (size_t)row * MEMW + cb + bj * 128 + 16 * n) = acc[ai][bj][m][n]; }
    }
};
struct EpiUp {
    static constexpr bool PERM = false, AFTER_DRAIN = false, KEEP = false;
    const float* SSQ; bf16_t* ACT;
    __device__ __forceinline__ void operator()(const f32x4 (&acc)[2][2][4][2], const pg8::Unit& u, int wr, int wc, int fr, int fq) const {
        const int rowb = u.pm * 256 + wr * 64 + fr, cb = u.pn * 256 + 32 * wc + 4 * fq;
#pragma unroll
        for (int ai = 0; ai < 2; ++ai)
#pragma unroll
            for (int m = 0; m < 4; ++m) { const int row = rowb + ai * 128 + m * 16; const float rs = rstd32(SSQ, row);
#pragma unroll
                for (int bj = 0; bj < 2; ++bj)
#pragma unroll
                    for (int n = 0; n < 2; ++n) { f32x4 v = acc[ai][bj][m][n] * rs; v.x = fmaxf(v.x, 0.f); v.y = fmaxf(v.y, 0.f); v.z = fmaxf(v.z, 0.f); v.w = fmaxf(v.w, 0.f);
                        st_bf4(ACT + (size_t)row * DFF + cb + bj * 128 + 16 * n, v * v); } }
    }
};
__device__ __forceinline__ void final_norm_row(float* y, const float* ssq, int np, const float* g, int lane) {
    float s = 0.f; for (int i = lane; i < np; i += 64) s += ssq[i]; s = wave_sum(s);
    const float rs = 1.0f / sqrtf(s * (1.0f / DM) + EPS);
    GAS f32x4* yr = (GAS f32x4*)y + lane; const GAS f32x4* gr = (const GAS f32x4*)g + lane;
#pragma unroll
    for (int j = 0; j < 8; ++j) { const f32x4 v = yr[64 * j], gg = gr[64 * j]; yr[64 * j] = v * rs * gg; }
}
__device__ __forceinline__ float rstd_n(const float* ssq, int n) { float s = 0.f; for (int i = 0; i < n; ++i) s += ssq[i]; return 1.0f / sqrtf(s * (1.0f / DM) + EPS); }
constexpr int N_PHASES = 13;
__global__ void __launch_bounds__(NWAVES * 64, 2) mega_fwd(Args args) {
    extern __shared__ __attribute__((aligned(16))) unsigned char lds_raw[];
    Frame F;
    F.lds = (LAS unsigned char*)lds_raw; F.ws = args.ws; F.out = args.out;
    F.tid = threadIdx.x; F.lane = F.tid & 63; F.wave = __builtin_amdgcn_readfirstlane(F.tid >> 6);
    F.G = gridDim.x; { const int bx = blockIdx.x; F.vcu = (F.G % 8 == 0) ? (bx % 8) * (F.G / 8) + bx / 8 : bx; }
    volatile LAS unsigned* MISC = (volatile LAS unsigned*)(F.lds + MISC_OFF);
    for (int u = F.tid; u < (LDS_BYTES - LDSCTL_OFF) / 4; u += NWAVES * 64) ((LAS unsigned*)(F.lds + LDSCTL_OFF))[u] = 0u;
    __syncthreads();
    unsigned char* ws = args.ws;
    const bool multi = (args.ph_hi - args.ph_lo) > 1;
    XcdBarrier bar; bar.bar = (unsigned*)(ws + WS_CTL) + CW_BAR; bar.x = 0; bar.st = nullptr;
    if (multi) bar = xcd_barrier_post((unsigned*)(ws + WS_CTL) + CW_BAR, MISC + 8);
    const int lo = args.ph_lo, hi = args.ph_hi, G = F.G, cid = (int)blockIdx.x;
    LAS unsigned char* lds = F.lds; LAS float* red = (LAS float*)lds;
#ifndef PH_MASK
#define PH_MASK 0xFFFF
#endif
#define PHASE_ON(k) ((PH_MASK >> (k)) & 1)
#ifndef REP_MASK
#define REP_MASK 0
#endif
#define NREP(k) (1 + ((REP_MASK >> (k)) & 1))
#ifndef P4_SEL
#define P4_SEL 7
#endif
#ifndef SUBREP_MASK
#define SUBREP_MASK 0
#endif
#define SUBREP(k) (1 + ((SUBREP_MASK >> (k)) & 1))
#define IN(k) (lo <= (k) && (k) < hi)
#define SEAM(k) do { if (IN(k) && IN((k) + 1)) xcd_barrier(bar); } while (0)
    float* out = args.out;
    unsigned char* sm = ws + WS_SMP;

    for (int rep_ = 0; rep_ < NREP(0) && PHASE_ON(0) && IN(0); ++rep_) { if (rep_) xcd_barrier(bar); p0_prologue(F, args); }
    SEAM(0);
    for (int rep_ = 0; rep_ < NREP(1) && PHASE_ON(1) && IN(1); ++rep_) { if (rep_) xcd_barrier(bar);
        {
            pg8::Gemm g{(const bf16_t*)(ws + WS_XN), (const bf16_t*)(ws + WS_WT1), MP, NV1, DM};
            OrderX S; S.initx(MP, NV1, G, cid, 8, 32, 43, 4);
            EpiIn E{ws, out};
            pg8::gemm_phase<EpiIn, OrderX, true, true>(lds, g, S, E);
        }
        for (int nb = cid; nb < NV1 / 32; nb += G) {
            const f32x16 acc = skinny_partial((const bf16_t*)(sm + SM_XN), DM, (const bf16_t*)(ws + WS_WT1), DM, nb, F.wave, F.lane);
            float v1, v2; skinny_reduce(acc, red, F.wave, F.lane, F.tid, v1, v2);
            epi_in_sample(ws, out, F.tid >> 4, nb, F.tid & 15, v1, v2);
        }
    }
    SEAM(1);
    for (int rep_ = 0; rep_ < NREP(2) && PHASE_ON(2) && IN(2); ++rep_) { if (rep_) xcd_barrier(bar);
        for (int u = F.vcu; u < 1056 + 512 + 256 + 8; u += G) {
            if (u < 1056) { const int b = u / 528, x = u % 528; int qb = (int)((sqrtf(8.0f * x + 1.0f) - 1.0f) * 0.5f); while ((qb + 1) * (qb + 2) / 2 <= x) ++qb; while (qb * (qb + 1) / 2 > x) --qb;
                d1_unit(F, b, qb, x - qb * (qb + 1) / 2); }
            else if (u < 1568) { const int x = u - 1056; r1_unit(F, x >> 5, x & 31); }
            else if (u < 1824) { const int x = u - 1568; s1_unit(F, args, x >> 5, x & 31); }
            else { if (F.wave == 0) s1_tail(F, u - 1824); }
        }
    }
    SEAM(2);
    for (int rep_ = 0; rep_ < NREP(3) && PHASE_ON(3) && IN(3); ++rep_) { if (rep_) xcd_barrier(bar);
        for (int sr_ = 0; sr_ < SUBREP(0); ++sr_) if (F.vcu < MS) s2_row(F, F.vcu);
        for (int sr_ = 0; sr_ < SUBREP(1); ++sr_) r2_scan(F);
        for (int sr_ = 0; sr_ < SUBREP(2); ++sr_) for (int row = F.vcu * NWAVES + F.wave; row < MP; row += G * NWAVES) d2_row(F, row);
    }
    SEAM(3);
    for (int rep_ = 0; rep_ < NREP(4) && PHASE_ON(4) && IN(4); ++rep_) { if (rep_) xcd_barrier(bar);
        for (int sr_ = 0; sr_ < SUBREP(3) && (P4_SEL & 1); ++sr_) for (int u = F.vcu; u < 256; u += G) d3_unit(F, u >> 7, (u >> 6) & 1, 63 - (u & 63));
        for (int sr_ = 0; sr_ < SUBREP(4) && (P4_SEL & 2); ++sr_) for (int u = F.vcu; u < 256; u += G) r3_unit(F, args, u >> 7, (u >> 2) & 31, u & 3);
        for (int sr_ = 0; sr_ < SUBREP(5) && (P4_SEL & 4); ++sr_) { const int u = ((F.vcu >> 6) * 24) + (F.vcu & 63) - 40; if ((F.vcu & 63) >= 40 && u < 96) { if (u < 32) s3_attn_unit(F, args, u); else s3_ret_unit(F, args, u - 32); } }
    }
    SEAM(4);
    for (int rep_ = 0; rep_ < NREP(5) && PHASE_ON(5) && IN(5); ++rep_) { if (rep_) xcd_barrier(bar);
        {
            pg8::Gemm g{(const bf16_t*)(ws + WS_RETY), (const bf16_t*)(ws + WS_WRO), MP, DM, 1024};
            OrderDual S; S.init(MP, DM, G, cid);
            EpiMerge E{(const bf16_t*)(ws + WS_GA), (const bf16_t*)(ws + WS_GB), (bf16_t*)(ws + WS_MERGED)};
            pg8::gemm_phase<EpiMerge, OrderDual, false, true>(lds, g, S, E);
        }
        for (int nb = cid; nb < DM / 32; nb += G) {
            const f32x16 a1 = skinny_partial((const bf16_t*)(sm + SM_RETY), 1024, (const bf16_t*)(ws + WS_WRO), 1024, nb, F.wave, F.lane);
            const f32x16 a2 = skinny_partial((const bf16_t*)(sm + SM_DSAO), 1024, (const bf16_t*)(ws + WS_WDO), 1024, nb, F.wave, F.lane);
            float y1, y2, z1, z2; skinny_reduce(a1, red, F.wave, F.lane, F.tid, y1, y2); skinny_reduce(a2, red, F.wave, F.lane, F.tid, z1, z2);
            const int row = F.tid >> 4, col = nb * 32 + (F.tid & 15); const size_t o = (size_t)row * DM + col;
            const bf16_t* ga = (const bf16_t*)(sm + SM_GA); const bf16_t* gb = (const bf16_t*)(sm + SM_GB); bf16_t* mg = (bf16_t*)(sm + SM_MERGED);
            st1(mg + o, bf2f(ga[o]) * y1 + bf2f(gb[o]) * z1); st1(mg + o + 16, bf2f(ga[o + 16]) * y2 + bf2f(gb[o + 16]) * z2);
        }
    }
    SEAM(5);
    for (int rep_ = 0; rep_ < NREP(6) && PHASE_ON(6) && IN(6); ++rep_) { if (rep_) xcd_barrier(bar);
        {
            pg8::Gemm g{(const bf16_t*)(ws + WS_MERGED), (const bf16_t*)(ws + WS_WO), MP, DM, DM};
            pg8::StaticOrder S; S.init(MP, DM, G, cid);
            EpiResid E{(const float*)args.in[I_XP], (float*)(ws + WS_H1), (bf16_t*)(ws + WS_H1B), (float*)(ws + WS_SSQ)};
            pg8::gemm_phase<EpiResid, pg8::StaticOrder, false, true>(lds, g, S, E);
        }
        for (int nb = cid; nb < DM / 32; nb += G) {
            const f32x16 a1 = skinny_partial((const bf16_t*)(sm + SM_MERGED), DM, (const bf16_t*)(ws + WS_WO), DM, nb, F.wave, F.lane);
            float y1, y2; skinny_reduce(a1, red, F.wave, F.lane, F.tid, y1, y2);
            const int row = F.tid >> 4, col = nb * 32 + (F.tid & 15); const size_t o = (size_t)row * DM + col; const float* xs = (const float*)args.in[I_XS];
            y1 += xs[o]; y2 += xs[o + 16]; ((float*)(sm + SM_H1))[o] = y1; ((float*)(sm + SM_H1))[o + 16] = y2; st1((bf16_t*)(sm + SM_H1B) + o, y1); st1((bf16_t*)(sm + SM_H1B) + o + 16, y2);
            const float s = sum16(y1 * y1 + y2 * y2); if ((F.tid & 15) == 0) ((float*)(sm + SM_SSQ))[row * 64 + nb] = s;
        }
    }
    SEAM(6);
    for (int rep_ = 0; rep_ < NREP(7) && PHASE_ON(7) && IN(7); ++rep_) { if (rep_) xcd_barrier(bar);
        {
            pg8::Gemm g{(const bf16_t*)(ws + WS_H1B), (const bf16_t*)(ws + WS_WMQ), MP, MEMW, DM / 4, DM};
            OrderSplitK S{MP / 256, MEMW / 256, 4, G, cid};
            EpiQmPart E{(float*)(ws + WS_QMP)};
            pg8::gemm_phase<EpiQmPart, OrderSplitK, false, true>(lds, g, S, E);
        }
        for (int nb = cid; nb < MEMW / 32; nb += G) {
            const f32x16 a1 = skinny_partial((const bf16_t*)(sm + SM_H1B), DM, (const bf16_t*)(ws + WS_WMQ), DM, nb, F.wave, F.lane);
            float y1, y2; skinny_reduce(a1, red, F.wave, F.lane, F.tid, y1, y2);
            const int row = F.tid >> 4, col = nb * 32 + (F.tid & 15); const float rs = rstd_n((const float*)(sm + SM_SSQ) + row * 64, 64);
            st1((bf16_t*)(sm + SM_QM) + row * MEMW + col, y1 * rs); st1((bf16_t*)(sm + SM_QM) + row * MEMW + col + 16, y2 * rs);
        }
    }
    SEAM(7);
    for (int rep_ = 0; rep_ < NREP(8) && PHASE_ON(8) && IN(8); ++rep_) { if (rep_) xcd_barrier(bar);
        for (int u = F.vcu; u < 136; u += G) { if (u < 128) xattn_unit(F, u >> 6, (u >> 4) & 3, u & 15); else s7_xattn_unit(F, u - 128); }
    }
    SEAM(8);
    for (int rep_ = 0; rep_ < NREP(9) && PHASE_ON(9) && IN(9); ++rep_) { if (rep_) xcd_barrier(bar);
        {
            pg8::Gemm g{(const bf16_t*)(ws + WS_OM), (const bf16_t*)(ws + WS_WMO), MP, DM, MEMW};
            pg8::StaticOrder S; S.init(MP, DM, G, cid);
            EpiResid E{(const float*)(ws + WS_H1), (float*)(ws + WS_H1), (bf16_t*)(ws + WS_H1B), (float*)(ws + WS_SSQ + 1 * MiB)};
            pg8::gemm_phase<EpiResid, pg8::StaticOrder, false, true>(lds, g, S, E);
        }
        for (int nb = cid; nb < DM / 32; nb += G) {
            const f32x16 a1 = skinny_partial((const bf16_t*)(sm + SM_OM), MEMW, (const bf16_t*)(ws + WS_WMO), MEMW, nb, F.wave, F.lane);
            float y1, y2; skinny_reduce(a1, red, F.wave, F.lane, F.tid, y1, y2);
            const int row = F.tid >> 4, col = nb * 32 + (F.tid & 15); const size_t o = (size_t)row * DM + col; float* h = (float*)(sm + SM_H1);
            y1 += h[o]; y2 += h[o + 16]; h[o] = y1; h[o + 16] = y2; st1((bf16_t*)(sm + SM_H1B) + o, y1); st1((bf16_t*)(sm + SM_H1B) + o + 16, y2);
            const float s = sum16(y1 * y1 + y2 * y2); if ((F.tid & 15) == 0) ((float*)(sm + SM_SSQ))[2048 + row * 64 + nb] = s;
        }
    }
    SEAM(9);
    for (int rep_ = 0; rep_ < NREP(10) && PHASE_ON(10) && IN(10); ++rep_) { if (rep_) xcd_barrier(bar);
        {
            pg8::Gemm g{(const bf16_t*)(ws + WS_H1B), (const bf16_t*)(ws + WS_WUP), MP, DFF, DM};
            pg8::StaticOrder S; S.init(MP, DFF, G, cid);
            EpiUp E{(const float*)(ws + WS_SSQ + 1 * MiB), (bf16_t*)(ws + WS_ACT)};
            pg8::gemm_phase<EpiUp, pg8::StaticOrder, true, true>(lds, g, S, E);
        }
        for (int nb = cid; nb < DFF / 32; nb += G) {
            const f32x16 a1 = skinny_partial((const bf16_t*)(sm + SM_H1B), DM, (const bf16_t*)(ws + WS_WUP), DM, nb, F.wave, F.lane);
            float y1, y2; skinny_reduce(a1, red, F.wave, F.lane, F.tid, y1, y2);
            const int row = F.tid >> 4, col = nb * 32 + (F.tid & 15); const float rs = rstd_n((const float*)(sm + SM_SSQ) + 2048 + row * 64, 64);
            y1 = fmaxf(y1 * rs, 0.f); y2 = fmaxf(y2 * rs, 0.f);
            st1((bf16_t*)(sm + SM_ACT) + (size_t)row * DFF + col, y1 * y1); st1((bf16_t*)(sm + SM_ACT) + (size_t)row * DFF + col + 16, y2 * y2);
        }
    }
    SEAM(10);
    for (int rep_ = 0; rep_ < NREP(11) && PHASE_ON(11) && IN(11); ++rep_) { if (rep_) xcd_barrier(bar);
        {
            pg8::Gemm g{(const bf16_t*)(ws + WS_ACT), (const bf16_t*)(ws + WS_WDN), MP, DM, DFF};
            pg8::StaticOrder S; S.init(MP, DM, G, cid);
            EpiResid E{(const float*)(ws + WS_H1), out + O_Y, nullptr, (float*)(ws + WS_SSQ + 2 * MiB)};
            pg8::gemm_phase<EpiResid, pg8::StaticOrder, false, true>(lds, g, S, E);
        }
        for (int nb = cid; nb < DM / 32; nb += G) {
            const f32x16 a1 = skinny_partial((const bf16_t*)(sm + SM_ACT), DFF, (const bf16_t*)(ws + WS_WDN), DFF, nb, F.wave, F.lane);
            float y1, y2; skinny_reduce(a1, red, F.wave, F.lane, F.tid, y1, y2);
            const int row = F.tid >> 4, col = nb * 32 + (F.tid & 15); const size_t o = (size_t)row * DM + col; const float* h = (const float*)(sm + SM_H1);
            y1 += h[o]; y2 += h[o + 16]; out[O_YS + o] = y1; out[O_YS + o + 16] = y2;
            const float s = sum16(y1 * y1 + y2 * y2); if ((F.tid & 15) == 0) ((float*)(sm + SM_SSQ))[4096 + row * 64 + nb] = s;
        }
    }
    SEAM(11);
    for (int rep_ = 0; rep_ < NREP(12) && PHASE_ON(12) && IN(12); ++rep_) { if (rep_) xcd_barrier(bar);
        const float* gf = (const float*)args.in[I_GFINAL];
        for (int row = F.vcu * NWAVES + F.wave; row < MP + MS; row += G * NWAVES) {
            if (row < MP) final_norm_row(out + O_Y + (size_t)row * DM, (const float*)(ws + WS_SSQ + 2 * MiB) + row, 1, gf, F.lane);
            else final_norm_row(out + O_YS + (size_t)(row - MP) * DM, (const float*)(sm + SM_SSQ) + 4096 + (row - MP) * 64, 64, gf, F.lane);
        }
    }
#undef IN
#undef SEAM
}

#ifndef HOST_REP_MASK
#define HOST_REP_MASK 0
#endif
#ifndef MK_N_LAUNCHES
#define MK_N_LAUNCHES 1
#endif
extern "C" void kernel_launch(void* const* d_in, const int* in_sizes, int n_in, void* d_out, int out_size, void* d_ws, size_t ws_size, hipStream_t stream) {
    static int grid = 0;
    if (grid == 0) {
        if (n_in != 26 || ws_size < WS_END) { fprintf(stderr, "kernel_launch: expected 26 inputs and >= %zu bytes of workspace; got %d inputs, %zu bytes\n", (size_t)WS_END, n_in, ws_size); grid = -1; return; }
        int dev = 0, cus = 0, per_cu = 0;
        if (hipGetDevice(&dev) != hipSuccess || hipDeviceGetAttribute(&cus, hipDeviceAttributeMultiprocessorCount, dev) != hipSuccess) { grid = -1; return; }
        if (hipFuncSetAttribute((const void*)mega_fwd, hipFuncAttributeMaxDynamicSharedMemorySize, LDS_BYTES) != hipSuccess) { fprintf(stderr, "kernel_launch: hipFuncSetAttribute failed\n"); grid = -1; return; }
        if (hipOccupancyMaxActiveBlocksPerMultiprocessor(&per_cu, (const void*)mega_fwd, NWAVES * 64, LDS_BYTES) != hipSuccess || per_cu < 1)
            fprintf(stderr, "kernel_launch: occupancy query reports %d workgroups per CU\n", per_cu);
        (void)hipGetLastError();
        grid = cus;
    }
    if (grid < 0) return;
    if (hipMemsetAsync((char*)d_ws + WS_CTL, 0, CTL_ZERO_BYTES, stream) != hipSuccess) return;
    Args a{};
    for (int i = 0; i < 26; ++i) a.in[i] = d_in[i];
    a.out = (float*)d_out; a.ws = (unsigned char*)d_ws;
    if (MK_N_LAUNCHES == 1) { a.ph_lo = 0; a.ph_hi = N_PHASES; hipLaunchKernelGGL(mega_fwd, dim3(grid), dim3(NWAVES * 64), LDS_BYTES, stream, a); }
    else for (int p = 0; p < N_PHASES; ++p) { a.ph_lo = p; a.ph_hi = p + 1; for (int r = 0; r < 1 + ((HOST_REP_MASK >> p) & 1); ++r) hipLaunchKernelGGL(mega_fwd, dim3(grid), dim3(NWAVES * 64), LDS_BYTES, stream, a); }
    const hipError_t le = hipPeekAtLastError();
    if (le != hipSuccess) fprintf(stderr, "kernel_launch: launch failed: %s\n", hipGetErrorName(le));
}
```
